# Optimizing an MI355X kernel written in HIP

```python
import math
import jax, jax.numpy as jnp
from jax import lax
import numpy as np

D_MODEL = 1024
BATCH = 2
SEQ = 16384
DEPTH = 4

GRID_W = 64
CTX_LEN = 256
N_MIXERS = 3
N_HY = (DEPTH + 2) // 3
N_GD = (DEPTH + 1) // 3
N_FN = DEPTH // 3

DN_ALPHA = (2 * DEPTH) ** 0.25
DN_BETA = (8 * DEPTH) ** -0.25
LN_EPS = 1e-5
N_MOD = 6

HY_CONV = 3
HY_EMB = 33
HY_BANDS = (HY_EMB - 1) // 2
HY_FFN = 64
HY_SHIFT = 0.05
HY_TARGET = 1e-2
HY_MIN_DECAY = math.log(HY_TARGET) / 1.5
HY_MAX_DECAY = math.log(HY_TARGET) / 0.3
HY_FILTER_INIT = 0.02

GD_HEADS = 8
GD_DK = 128
GD_DV = 128
GD_WIDTH = GD_HEADS * GD_DK
GD_CONV = 3
GD_CHUNK = 64
GD_IN = 4 * GD_WIDTH + 4 * GD_HEADS

FN_GROUPS = 4

PK_HEADS = 8
PK_NKEYS = 128
PK_EXPERTS = PK_NKEYS * PK_NKEYS
PK_DH = 128
PK_TOPK = 16
PK_BLOCK = 128

kernel_name = "hybrid_hyena_gdn_fnet_peer_diffusion_trunk"


def layer_norm(x, g, b):
    xf = x.astype(jnp.float32)
    mu = jnp.mean(xf, -1, keepdims=True)
    var = jnp.mean(jnp.square(xf - mu), -1, keepdims=True)
    return ((xf - mu) * lax.rsqrt(var + LN_EPS) * g + b).astype(x.dtype)


def conv_centred(u, w):
    k_w = w.shape[0]
    r = k_w // 2
    length = u.shape[1]
    up = jnp.pad(u, ((0, 0), (r, r), (0, 0)))
    out = up[:, 0:length] * w[0]
    for k in range(1, k_w):
        out = out + up[:, k:k + length] * w[k]
    return out


def sincos_2d(rows, dim):
    quarter = dim // 4
    omega = 1.0 / (10000.0 ** (jnp.arange(quarter, dtype=jnp.float32) / quarter))
    er = jnp.arange(rows, dtype=jnp.float32)[:, None] * omega
    ec = jnp.arange(GRID_W, dtype=jnp.float32)[:, None] * omega
    emb_r = jnp.concatenate([jnp.sin(er), jnp.cos(er)], -1)
    emb_c = jnp.concatenate([jnp.sin(ec), jnp.cos(ec)], -1)
    pe = jnp.concatenate([
        jnp.broadcast_to(emb_r[:, None, :], (rows, GRID_W, dim // 2)),
        jnp.broadcast_to(emb_c[None, :, :], (rows, GRID_W, dim // 2))], -1)
    return pe.reshape(rows * GRID_W, dim)


def hyena_filter(length, f_w1, f_b1, f_w2, f_b2, f_w3):
    d = f_w3.shape[1] // 2
    t = jnp.arange(length, dtype=jnp.float32) / length
    bands = jnp.linspace(1e-4, HY_BANDS - 1, HY_BANDS, dtype=jnp.float32)
    ang = 2.0 * jnp.pi * t[:, None] * bands
    feat = jnp.concatenate([t[:, None], jnp.cos(ang), -jnp.sin(ang)], -1)
    hdn = jnp.sin(feat @ f_w1 + f_b1)
    hdn = jnp.sin(hdn @ f_w2 + f_b2)
    hf = (hdn @ f_w3).astype(jnp.float32)
    deltas = jnp.abs(jnp.linspace(HY_MIN_DECAY, HY_MAX_DECAY, d, dtype=jnp.float32))
    win = jnp.exp(-t[:, None] * deltas) + HY_SHIFT
    h_fwd = hf[:, :d] * win
    h_bwd = hf[:, d:] * win
    return jnp.concatenate([h_fwd, jnp.zeros((1, d), jnp.float32), h_bwd[:0:-1]], 0)


def hyena_mixer(h, in_w, in_b, conv_w, f_w1, f_b1, f_w2, f_b2, f_w3, skip, out_w, out_b):
    length = h.shape[1]
    u = conv_centred(h @ in_w + in_b, conv_w)
    x0, x1, v = jnp.split(u, 3, axis=-1)
    z = (v * x1).astype(jnp.float32)
    filt = hyena_filter(length, f_w1, f_b1, f_w2, f_b2, f_w3)
    n = 2 * length
    y = jnp.fft.irfft(jnp.fft.rfft(z, n=n, axis=1) * jnp.fft.rfft(filt, n=n, axis=0)[None],
                      n=n, axis=1)[:, :length]
    y = (y + skip * z) * x0
    return y.astype(h.dtype) @ out_w + out_b


def to_heads(t):
    b, length, _ = t.shape
    return jnp.transpose(t.reshape(b, length, GD_HEADS, -1), (0, 2, 1, 3)).astype(jnp.float32)


def l2norm(t):
    return t * lax.rsqrt(jnp.sum(t * t, -1, keepdims=True) + 1e-6)


def gdn_inputs(h, in_w, conv_w, a_log, dt_bias, with_query):
    b, length, _ = h.shape
    w = GD_WIDTH
    u = h @ in_w

    def branch(s):
        cols = slice(s * w, (s + 1) * w)
        return to_heads(jax.nn.silu(conv_centred(u[..., cols], conv_w[:, cols])))

    k = l2norm(branch(1))
    v = branch(2)
    q = l2norm(branch(0)) * GD_DK ** -0.5 if with_query else None
    z = u[..., 3 * w:4 * w] if with_query else None
    ab = u[..., 4 * w:].astype(jnp.float32).reshape(b, length, 2, 2, GD_HEADS)
    ab = jnp.transpose(ab, (2, 3, 0, 4, 1))
    g = -jnp.exp(a_log)[:, None, :, None] * jax.nn.softplus(ab[0] + dt_bias[:, None, :, None])
    beta = jax.nn.sigmoid(ab[1])
    return q, k, v, g, beta, z


def gated_delta_chunked(q, k, v, g, beta, s0):
    b, nh, length, dk = k.shape
    dv = v.shape[-1]
    c = GD_CHUNK
    n = length // c
    k = k.reshape(b, nh, n, c, dk)
    v = v.reshape(b, nh, n, c, dv)
    gc = jnp.cumsum(g.reshape(b, nh, n, c), -1)
    beta = beta.reshape(b, nh, n, c)
    causal = jnp.tril(jnp.ones((c, c), bool))
    strict = jnp.tril(jnp.ones((c, c), bool), -1)
    decay = jnp.exp(jnp.where(causal, gc[..., :, None] - gc[..., None, :], -jnp.inf))
    kb = k * beta[..., None]
    a_mat = jnp.where(strict, jnp.einsum('bhncd,bhnsd->bhncs', kb, k) * decay, 0.0) + jnp.eye(c, dtype=jnp.float32)
    rhs = jnp.concatenate([v * beta[..., None], kb * jnp.exp(gc)[..., None]], -1)
    sol = lax.linalg.triangular_solve(a_mat, rhs, left_side=True, lower=True, unit_diagonal=True)
    u_c, w_c = sol[..., :dv], sol[..., dv:]
    kd = k * jnp.exp(gc[..., -1:] - gc)[..., None]
    glast = jnp.exp(gc[..., -1])
    with_out = q is not None
    xs = [kd, u_c, w_c, glast]
    if with_out:
        q = q.reshape(b, nh, n, c, dk)
        xs += [q * jnp.exp(gc)[..., None], jnp.einsum('bhncd,bhnsd->bhncs', q, k) * decay]
    xs = tuple(jnp.moveaxis(t, 2, 0) for t in xs)

    def step(s, xs_i):
        kd_i, u_i, w_i, gl_i = xs_i[:4]
        v_new = u_i - jnp.einsum('bhcd,bhde->bhce', w_i, s)
        s_new = s * gl_i[..., None, None] + jnp.einsum('bhcd,bhce->bhde', kd_i, v_new)
        if with_out:
            qg_i, attn_i = xs_i[4:]
            o_i = jnp.einsum('bhcd,bhde->bhce', qg_i, s) + jnp.einsum('bhcs,bhse->bhce', attn_i, v_new)
        else:
            o_i = None
        return s_new, o_i

    s_fin, o = lax.scan(step, s0, xs)
    if with_out:
        o = jnp.moveaxis(o, 0, 2).reshape(b, nh, length, dv)
    return o, s_fin


def gdn_out(o, z, norm_g, out_w):
    b, nh, length, dv = o.shape
    o = jnp.transpose(o, (0, 2, 1, 3))
    o = o * lax.rsqrt(jnp.mean(o * o, -1, keepdims=True) + 1e-6) * norm_g
    o = o.reshape(b, length, nh * dv) * jax.nn.silu(z.astype(jnp.float32))
    return o.astype(z.dtype) @ out_w


def gdn_mixer(hc, hl, in_w, conv_w, a_log, dt_bias, norm_g, out_w, ctx_out):
    qc, kc, vc, gcx, bcx, zc = gdn_inputs(hc, in_w, conv_w, a_log, dt_bias, ctx_out)
    ql, kl, vl, glt, blt, zl = gdn_inputs(hl, in_w, conv_w, a_log, dt_bias, True)
    s0 = jnp.zeros((hl.shape[0], GD_HEADS, GD_DK, GD_DV), jnp.float32)

    def rev(t):
        return None if t is None else jnp.flip(t, axis=2)

    oc_f, sc_f = gated_delta_chunked(qc, kc, vc, gcx[0], bcx[0], s0)
    ol_f, _ = gated_delta_chunked(ql, kl, vl, glt[0], blt[0], sc_f)
    oc_b, sc_b = gated_delta_chunked(rev(qc), rev(kc), rev(vc), rev(gcx[1]), rev(bcx[1]), s0)
    ol_b, _ = gated_delta_chunked(rev(ql), rev(kl), rev(vl), rev(glt[1]), rev(blt[1]), sc_b)
    yl = gdn_out(ol_f + rev(ol_b), zl, norm_g, out_w)
    yc = gdn_out(oc_f + rev(oc_b), zc, norm_g, out_w) if ctx_out else None
    return yc, yl


def fnet_mixer(h, out_w, out_b):
    b, length, d = h.shape
    hg = h.reshape(b, length, FN_GROUPS, d // FN_GROUPS).astype(jnp.float32)
    y = jnp.fft.fftn(hg, axes=(1, 3), norm='ortho').real.reshape(b, length, d)
    return y.astype(h.dtype) @ out_w + out_b


def peer_ffn(h, wq, keys, u_tab, v_tab):
    b, length, d = h.shape
    blocks = h.reshape(-1, PK_BLOCK, d)

    def block(hb):
        q = (hb @ wq).reshape(PK_BLOCK, PK_HEADS, 2, PK_DH)
        s = jnp.einsum('thpd,hpkd->thpk', q, keys).astype(jnp.float32)
        sv, si = lax.top_k(s, PK_TOPK)
        cand = (sv[:, :, 0, :, None] + sv[:, :, 1, None, :]).reshape(PK_BLOCK, PK_HEADS, PK_TOPK * PK_TOPK)
        cv, ci = lax.top_k(cand, PK_TOPK)
        i1 = jnp.take_along_axis(si[:, :, 0], ci // PK_TOPK, -1)
        i2 = jnp.take_along_axis(si[:, :, 1], ci % PK_TOPK, -1)
        idx = i1 * PK_NKEYS + i2
        gate = jax.nn.softmax(cv, -1)
        act = jax.nn.gelu(jnp.einsum('td,thkd->thk', hb, u_tab[idx]).astype(jnp.float32))
        return jnp.einsum('thk,thkd->td', (gate * act).astype(v_tab.dtype), v_tab[idx])

    return lax.map(block, blocks).reshape(b, length, d).astype(h.dtype)


def setup_inputs(seed: int = 0) -> dict:
    key = jax.random.key(seed)
    ks = iter(jax.random.split(key, 48))
    f32 = jnp.float32
    d = D_MODEL
    w = GD_WIDTH

    def nrm(shape, scale):
        return jax.random.normal(next(ks), shape, f32) * scale

    dt = jnp.exp(jax.random.uniform(next(ks), (N_GD, 2, GD_HEADS), f32, math.log(1e-3), math.log(1e-1)))
    return {
        'x': nrm((BATCH, SEQ, d), 1.0),
        'c': nrm((BATCH, d), 1.0),
        'ctx': nrm((BATCH, CTX_LEN, d), 1.0),
        'c_ctx': nrm((d,), 1.0),
        'ada_w': nrm((DEPTH, d, N_MOD * d), d ** -0.5),
        'ada_b': nrm((DEPTH, N_MOD * d), 0.02),
        'ln_g': 1.0 + nrm((DEPTH, 2, d), 0.02),
        'ln_b': nrm((DEPTH, 2, d), 0.02),
        'pk_wq': nrm((DEPTH, d, PK_HEADS * 2 * PK_DH), d ** -0.5),
        'pk_keys': nrm((DEPTH, PK_HEADS, 2, PK_NKEYS, PK_DH), PK_DH ** -0.5),
        'pk_u': nrm((DEPTH, PK_EXPERTS, d), d ** -0.5),
        'pk_v': nrm((DEPTH, PK_EXPERTS, d), DN_BETA),
        'hy_in_w': nrm((N_HY, d, 3 * d), d ** -0.5),
        'hy_in_b': nrm((N_HY, 3 * d), 0.02),
        'hy_conv': nrm((N_HY, HY_CONV, 3 * d), HY_CONV ** -0.5),
        'hy_f_w1': nrm((N_HY, HY_EMB, HY_FFN), HY_EMB ** -0.5),
        'hy_f_b1': nrm((N_HY, HY_FFN), 0.1),
        'hy_f_w2': nrm((N_HY, HY_FFN, HY_FFN), HY_FFN ** -0.5),
        'hy_f_b2': nrm((N_HY, HY_FFN), 0.1),
        'hy_f_w3': nrm((N_HY, HY_FFN, 2 * d), HY_FILTER_INIT * HY_FFN ** -0.5),
        'hy_skip': nrm((N_HY, d), 1.0),
        'hy_out_w': nrm((N_HY, d, d), DN_BETA * d ** -0.5),
        'hy_out_b': nrm((N_HY, d), 0.02),
        'gd_in_w': nrm((N_GD, d, GD_IN), d ** -0.5),
        'gd_conv': nrm((N_GD, GD_CONV, 3 * w), GD_CONV ** -0.5),
        'gd_a_log': jnp.log(jax.random.uniform(next(ks), (N_GD, 2, GD_HEADS), f32, 1.0, 16.0)),
        'gd_dt_bias': dt + jnp.log(-jnp.expm1(-dt)),
        'gd_norm_g': 1.0 + nrm((N_GD, GD_DV), 0.02),
        'gd_out_w': nrm((N_GD, w, d), DN_BETA * w ** -0.5),
        'fn_out_w': nrm((N_FN, d, d), DN_BETA * d ** -0.5),
        'fn_out_b': nrm((N_FN, d), 0.02),
    }


def reference(x, c, ctx, c_ctx, ada_w, ada_b, ln_g, ln_b, pk_wq, pk_keys, pk_u, pk_v,
              hy_in_w, hy_in_b, hy_conv, hy_f_w1, hy_f_b1, hy_f_w2, hy_f_b2, hy_f_w3, hy_skip,
              hy_out_w, hy_out_b, gd_in_w, gd_conv, gd_a_log, gd_dt_bias, gd_norm_g, gd_out_w,
              fn_out_w, fn_out_b):
    b, length, d = x.shape
    rows = length // GRID_W
    x = x + sincos_2d(rows, d).astype(x.dtype)[None]
    xc = ctx
    gdn_layers = [i for i in range(DEPTH) if i % N_MIXERS == 1]
    ctx_until = gdn_layers[-1] if gdn_layers else -1
    hc = None
    mod_c = None
    for i in range(DEPTH):
        kind, j = i % N_MIXERS, i // N_MIXERS
        ctx_in, ctx_out = i <= ctx_until, i < ctx_until
        mod = (jax.nn.silu(c) @ ada_w[i] + ada_b[i]).reshape(b, N_MOD, 1, d)
        hl = x * (1 + mod[:, 1]) + mod[:, 0]
        if ctx_in:
            mod_c = (jax.nn.silu(c_ctx) @ ada_w[i] + ada_b[i]).reshape(N_MOD, 1, d)
            hc = xc * (1 + mod_c[1]) + mod_c[0]
        yc = None
        if kind == 0:
            hy = (hy_in_w[j], hy_in_b[j], hy_conv[j], hy_f_w1[j], hy_f_b1[j], hy_f_w2[j],
                  hy_f_b2[j], hy_f_w3[j], hy_skip[j], hy_out_w[j], hy_out_b[j])
            yl = hyena_mixer(hl, *hy)
            if ctx_out:
                yc = hyena_mixer(hc, *hy)
        elif kind == 1:
            yc, yl = gdn_mixer(hc, hl, gd_in_w[j], gd_conv[j], gd_a_log[j], gd_dt_bias[j],
                               gd_norm_g[j], gd_out_w[j], ctx_out)
        else:
            yl = fnet_mixer(hl, fn_out_w[j], fn_out_b[j])
            if ctx_out:
                yc = fnet_mixer(hc, fn_out_w[j], fn_out_b[j])
        pk = (pk_wq[i], pk_keys[i], pk_u[i], pk_v[i])
        x = layer_norm(DN_ALPHA * x + mod[:, 2] * yl, ln_g[i, 0], ln_b[i, 0])
        x = layer_norm(DN_ALPHA * x + mod[:, 5] * peer_ffn(x * (1 + mod[:, 4]) + mod[:, 3], *pk),
                       ln_g[i, 1], ln_b[i, 1])
        if ctx_out:
            xc = layer_norm(DN_ALPHA * xc + mod_c[2] * yc, ln_g[i, 0], ln_b[i, 0])
            xc = layer_norm(DN_ALPHA * xc + mod_c[5] * peer_ffn(xc * (1 + mod_c[4]) + mod_c[3], *pk),
                            ln_g[i, 1], ln_b[i, 1])
    return x
```

```cpp
#include <hip/hip_runtime.h>
#include <hip/hip_cooperative_groups.h>
#include <cstdio>
#include <cstdint>
namespace cg = cooperative_groups;

#ifndef KO_MASK
#define KO_MASK 0
#endif
#ifndef DUP_MASK
#define DUP_MASK 0
#endif
#define REP(bit) for (int rep_ = 0; rep_ < (((DUP_MASK) >> (bit)) & 1) + 1; ++rep_)
#define DRY(bit) ((((DUP_MASK) >> (bit)) & 1) && rep_ == 0)
#ifndef EXPERT_L2PROBE
#define EXPERT_L2PROBE 0
#endif
#ifndef EXPERT_VALU2
#define EXPERT_VALU2 0
#endif
#ifndef EXPERT_BYTES2
#define EXPERT_BYTES2 0
#endif
#ifndef BARRIER2
#define BARRIER2 0
#endif
#ifndef N_LAUNCH_MODE
#define N_LAUNCH_MODE 1
#endif

typedef unsigned short bf16_t;
typedef short bf16x8 __attribute__((ext_vector_type(8)));
typedef float f32x4 __attribute__((ext_vector_type(4)));
typedef int v8i32 __attribute__((ext_vector_type(8)));
#define DEV __device__ __forceinline__

constexpr int D = 1024, LSEQ = 16384, TL = 32768, CTXL = 256, TT = 33280;
constexpr int NT = 512;
constexpr float DN_ALPHA = 1.6817928305074290f;
constexpr float LN_EPS = 1e-5f;
constexpr int LDS_BYTES = 150 * 1024;

constexpr size_t AL(size_t x) { return (x + 255) & ~(size_t)255; }
constexpr size_t SZ_X = (size_t)TT * D * 4;
constexpr size_t OFF_X = 0;
constexpr size_t OFF_MOD = OFF_X + AL(SZ_X);
constexpr size_t OFF_W_HYIN = OFF_MOD + AL((size_t)4 * 3 * 6144 * 4);
constexpr size_t OFF_W_HYOUT = OFF_W_HYIN + AL((size_t)2 * 3072 * 1024 * 2);
constexpr size_t OFF_W_GDIN = OFF_W_HYOUT + AL((size_t)2 * 1024 * 1024 * 2);
constexpr size_t OFF_W_GDAB = OFF_W_GDIN + AL((size_t)4096 * 1024 * 2);
constexpr size_t OFF_W_GDOUT = OFF_W_GDAB + AL((size_t)256 * 1024 * 2);
constexpr size_t OFF_W_FNOUT = OFF_W_GDOUT + AL((size_t)1024 * 1024 * 2);
constexpr size_t OFF_W_DFT = OFF_W_FNOUT + AL((size_t)1024 * 1024 * 2);
constexpr size_t OFF_WQK = OFF_W_DFT + AL((size_t)256 * 256 * 2);
constexpr size_t OFF_H = OFF_WQK + AL((size_t)4 * 2048 * 1024 * 2);
constexpr size_t OFF_PT = OFF_H + AL((size_t)TT * D * 2);
constexpr size_t SZ_PT1 = (size_t)16384 * 1024 * 2;
constexpr size_t OFF_FILT = OFF_PT + AL(2 * SZ_PT1);
constexpr size_t SZ_FILT1 = (size_t)1024 * 16384 * 4;
constexpr size_t OFF_RA = OFF_FILT + AL(2 * SZ_FILT1 + 2 * (size_t)1024 * 256 * 4);
constexpr size_t SZ_RA = (size_t)4 * TT * D * 2;
constexpr size_t OFF_RB = OFF_RA + AL(SZ_RA);
constexpr size_t SZ_RB = (size_t)TT * 3072 * 2;
constexpr size_t OFF_RC = OFF_RB + AL(SZ_RB);
constexpr size_t SZ_RC = (size_t)TT * D * 4;
constexpr size_t OFF_BAR = OFF_RC + AL(SZ_RC);
constexpr size_t OFF_PE = OFF_BAR + 16384;
constexpr size_t WS_END = OFF_PE + (size_t)320 * 512 * 4;

struct Params {
  const float* in[31];
  float* out;
  unsigned char* ws;
  int ph_lo, ph_hi;
};
enum { I_X = 0, I_C, I_CTX, I_CCTX, I_ADAW, I_ADAB, I_LNG, I_LNB, I_PKWQ, I_PKKEYS, I_PKU, I_PKV,
       I_HYINW, I_HYINB, I_HYCONV, I_HYFW1, I_HYFB1, I_HYFW2, I_HYFB2, I_HYFW3, I_HYSKIP, I_HYOUTW, I_HYOUTB,
       I_GDINW, I_GDCONV, I_GDALOG, I_GDDTB, I_GDNORMG, I_GDOUTW, I_FNOUTW, I_FNOUTB };

extern __shared__ __attribute__((aligned(16))) unsigned char smem[];
__shared__ __attribute__((aligned(16))) unsigned long long g_ptab[34];
__device__ __forceinline__ unsigned long long ld_u64_uniform(int i) {
  const unsigned long long v = ((const volatile __attribute__((address_space(3))) unsigned long long*)g_ptab)[i];
  const unsigned lo = __builtin_amdgcn_readfirstlane((unsigned)v), hi = __builtin_amdgcn_readfirstlane((unsigned)(v >> 32));
  return ((unsigned long long)hi << 32) | lo;
}
__device__ __forceinline__ int tidx_of(int wave_u) {
  int l; asm volatile("v_mbcnt_lo_u32_b32 %0, -1, 0\n\tv_mbcnt_hi_u32_b32 %0, -1, %0" : "=v"(l));
  return (wave_u << 6) | l;
}
#define TIDX() tidx_of(p.ph_lo)
__device__ __forceinline__ int BIDX() { int t = blockIdx.x; asm volatile("" : "+s"(t)); return t; }
__device__ __forceinline__ int GDIM() { int t = gridDim.x; asm volatile("" : "+s"(t)); return t; }
#define GAS __attribute__((address_space(1)))
#define PIN(i) ((const float*)(const GAS float*)ld_u64_uniform(i))
#define POUT() ((float*)(GAS float*)ld_u64_uniform(31))
#define PWS() ((unsigned char*)(GAS unsigned char*)ld_u64_uniform(32))

DEV bf16_t f2bf(float f) { unsigned u = __float_as_uint(f); u += 0x7fffu + ((u >> 16) & 1u); return (bf16_t)(u >> 16); }
DEV float bf2f(bf16_t h) { return __uint_as_float(((unsigned)h) << 16); }
DEV unsigned pack2(float lo, float hi) { return (unsigned)f2bf(lo) | ((unsigned)f2bf(hi) << 16); }
DEV float bflo(unsigned u) { return __uint_as_float(u << 16); }
DEV float bfhi(unsigned u) { return __uint_as_float(u & 0xffff0000u); }
DEV float silu_f(float x) { return x / (1.f + __expf(-x)); }
DEV float gelu_tanh(float x) { float u = 0.7978845608028654f * (x + 0.044715f * x * x * x); float t = 1.f - 2.f / (1.f + __expf(2.f * u)); return 0.5f * x * (1.f + t); }
DEV float shfl_idx_f(float v, int src) { return __uint_as_float((unsigned)__builtin_amdgcn_ds_bpermute(src << 2, (int)__float_as_uint(v))); }
#define SHX(x, m) shfl_idx_f((x), (lane) ^ (m))
DEV float wave_sum(float v, int lane) {
#pragma unroll
  for (int o = 32; o > 0; o >>= 1) v += SHX(v, o);
  return v;
}
DEV void unpack16(const uint4& a, const uint4& b, float (&f)[16]) {
  f[0] = bflo(a.x); f[1] = bfhi(a.x); f[2] = bflo(a.y); f[3] = bfhi(a.y); f[4] = bflo(a.z); f[5] = bfhi(a.z); f[6] = bflo(a.w); f[7] = bfhi(a.w);
  f[8] = bflo(b.x); f[9] = bfhi(b.x); f[10] = bflo(b.y); f[11] = bfhi(b.y); f[12] = bflo(b.z); f[13] = bfhi(b.z); f[14] = bflo(b.w); f[15] = bfhi(b.w);
}
DEV void load16f(const float* p, float (&f)[16]) {
#pragma unroll
  for (int i = 0; i < 4; ++i) { float4 v = *(const float4*)(p + 4 * i); f[4 * i] = v.x; f[4 * i + 1] = v.y; f[4 * i + 2] = v.z; f[4 * i + 3] = v.w; }
}
DEV void store16f(float* p, const float (&f)[16]) {
#pragma unroll
  for (int i = 0; i < 4; ++i) *(float4*)(p + 4 * i) = make_float4(f[4 * i], f[4 * i + 1], f[4 * i + 2], f[4 * i + 3]);
}
DEV void store16bf(bf16_t* p, const float (&f)[16]) {
  uint4 a, b;
  a.x = pack2(f[0], f[1]); a.y = pack2(f[2], f[3]); a.z = pack2(f[4], f[5]); a.w = pack2(f[6], f[7]);
  b.x = pack2(f[8], f[9]); b.y = pack2(f[10], f[11]); b.z = pack2(f[12], f[13]); b.w = pack2(f[14], f[15]);
  *(uint4*)p = a; *(uint4*)(p + 8) = b;
}
DEV void load16bf(const bf16_t* p, float (&f)[16]) { const uint4 a = *(const uint4*)p, b = *(const uint4*)(p + 8); unpack16(a, b, f); }
DEV int modrow_of(int r) { return r < TL ? (r >> 14) : 2; }
DEV const float* mod_ptr(const float* MOD, int layer, int mr, int comp) { return MOD + ((size_t)(layer * 3 + mr) * 6 + comp) * 1024; }

DEV void ln_row(float (&v)[16], const float* g, const float* b, int lane) {
  float s = 0.f;
#pragma unroll
  for (int i = 0; i < 16; ++i) s += v[i];
  const float mu = wave_sum(s, lane) * (1.f / 1024.f);
  float q = 0.f;
#pragma unroll
  for (int i = 0; i < 16; ++i) { v[i] -= mu; q += v[i] * v[i]; }
  const float rs = rsqrtf(wave_sum(q, lane) * (1.f / 1024.f) + LN_EPS);
  float gg[16], bb[16];
  load16f(g + lane * 16, gg); load16f(b + lane * 16, bb);
#pragma unroll
  for (int i = 0; i < 16; ++i) v[i] = v[i] * rs * gg[i] + bb[i];
}

#define XB_TMO      128
#define XB_XCNT(j)  (256  + 64 * (j))
#define XB_XSUB(j)  (1280 + 64 * (j))
#define XB_XGEN(j)  (2304 + 64 * (j))
#define XB_TOP      3328
#define XB_TOPGEN   3392
#define XCD_BAR_WORDS 3456
#define XB_SPIN_CAP (1u << 22)
#define LAS __attribute__((address_space(3)))
DEV unsigned xb_ld(unsigned* p) { return __hip_atomic_load(p, __ATOMIC_RELAXED, __HIP_MEMORY_SCOPE_AGENT); }
DEV unsigned xb_add(unsigned* p, unsigned v) { return __hip_atomic_fetch_add(p, v, __ATOMIC_RELAXED, __HIP_MEMORY_SCOPE_AGENT); }
DEV unsigned xb_xcc_id() { return (unsigned)__builtin_amdgcn_s_getreg((3 << 11) | 20) & 0xFu; }
#define XB_SPIN(cond, bar) do { unsigned _sp = 0; while (cond) { __builtin_amdgcn_s_sleep(1); \
    if ((++_sp & 255u) == 0u) { if (xb_ld(&(bar)[XB_TMO])) break; if (_sp > XB_SPIN_CAP) { atomicAdd(&(bar)[XB_TMO], 1u); break; } } } } while (0)
struct XcdBarrier { unsigned* bar; unsigned x; volatile LAS unsigned* st; };
__shared__ __attribute__((aligned(16))) uint4 g_xbwords;
DEV XcdBarrier xcd_barrier_post(unsigned* bar, volatile LAS unsigned* st) {
  XcdBarrier b; b.bar = bar; b.x = xb_xcc_id(); b.st = st;
  if (threadIdx.x == 0) (void)xb_add(&bar[XB_XCNT(b.x)], 1u);
  return b;
}
DEV void xcd_barrier_complete(unsigned* bar, unsigned x, unsigned& nloc, unsigned& nx) {
  const unsigned G = gridDim.x * gridDim.y * gridDim.z;
  unsigned sum, cnt, mine, sp = 0u;
  for (;;) {
    sum = 0u; cnt = 0u; mine = 0u;
#pragma unroll
    for (unsigned j = 0; j < 16; ++j) { const unsigned c = xb_ld(&bar[XB_XCNT(j)]); sum += c; cnt += (c > 0u) ? 1u : 0u; mine = (j == x) ? c : mine; }
    if (sum == G) break;
    __builtin_amdgcn_s_sleep(1);
    if ((++sp & 255u) == 0u) { if (xb_ld(&bar[XB_TMO])) break; if (sp > XB_SPIN_CAP) { atomicAdd(&bar[XB_TMO], 1u); break; } }
  }
  nloc = mine > 0u ? mine : 1u; nx = cnt > 0u ? cnt : 1u;
}
DEV void xcd_barrier(const XcdBarrier& b, int wave_u) {
  asm volatile("s_waitcnt vmcnt(0)" ::: "memory");
  __syncthreads();
  if (tidx_of(wave_u) == 0) {
    unsigned* bar = b.bar;
    __builtin_amdgcn_s_waitcnt(0);
    unsigned nloc = b.st[0], nx = b.st[1];
    if (nloc == 0u) { xcd_barrier_complete(bar, b.x, nloc, nx); b.st[0] = nloc; b.st[1] = nx; }
    const unsigned old = xb_add(&bar[XB_XSUB(b.x)], 1u);
    const unsigned gen = old / nloc;
    if (old + 1u == (gen + 1u) * nloc) {
      __builtin_amdgcn_fence(__ATOMIC_RELEASE, "agent");
      asm volatile("s_waitcnt vmcnt(0)" ::: "memory");
      const unsigned og = xb_add(&bar[XB_TOP], 1u);
      const unsigned tg = og / nx;
      if (og + 1u == (tg + 1u) * nx) xb_add(&bar[XB_TOPGEN], 1u);
      else XB_SPIN(xb_ld(&bar[XB_TOPGEN]) == tg, bar);
      __builtin_amdgcn_fence(__ATOMIC_ACQUIRE, "agent");
      xb_add(&bar[XB_XGEN(b.x)], 1u);
      asm volatile("s_waitcnt vmcnt(0)" ::: "memory");
    } else {
      XB_SPIN(xb_ld(&bar[XB_XGEN(b.x)]) == gen, bar);
      __builtin_amdgcn_fence(__ATOMIC_ACQUIRE, "agent");
      asm volatile("s_waitcnt vmcnt(0)" ::: "memory");
    }
  }
  __syncthreads();
}
#define CEX(a, b) { const unsigned _mx = (a) > (b) ? (a) : (b); const unsigned _mn = (a) > (b) ? (b) : (a); (a) = _mx; (b) = _mn; }
DEV unsigned fkey(float x) { unsigned u = __float_as_uint(x); return (u & 0x80000000u) ? ~u : (u | 0x80000000u); }
DEV float keyf(unsigned k) { unsigned u = (k & 0x80000000u) ? (k & 0x7fffffffu) : ~k; return __uint_as_float(u); }
DEV void sort16_desc(unsigned (&k)[16]) {
#pragma unroll
  for (int size = 2; size <= 16; size <<= 1) {
#pragma unroll
    for (int stride = size >> 1; stride > 0; stride >>= 1) {
#pragma unroll
      for (int i = 0; i < 16; ++i) {
        const int j = i ^ stride;
        if (j > i) {
          if ((i & size) == 0) { CEX(k[i], k[j]); } else { CEX(k[j], k[i]); }
        }
      }
    }
  }
}
DEV void merge16_desc(unsigned (&best)[16], const unsigned (&cur)[16]) {
#pragma unroll
  for (int i = 0; i < 16; ++i) best[i] = best[i] > cur[15 - i] ? best[i] : cur[15 - i];
#pragma unroll
  for (int stride = 8; stride > 0; stride >>= 1) {
#pragma unroll
    for (int i = 0; i < 16; ++i) { const int j = i ^ stride; if (j > i) { CEX(best[i], best[j]); } }
  }
}

DEV void gemm_phase(const Params& p, const bf16_t* gA, const bf16_t* gBt, void* gC, const float* gbias, const int gM, const int gN, const int gK, const int glda, const int gldb, const int gldc,
                    const int gnbatch, const int gmode, const long gsA, const long gsB, const long gsC) {
  const int tid = TIDX(), lane = tid & 63, wave = tid >> 6, wm = wave >> 1, wn = wave & 1;
  const int g = lane >> 4, c = lane & 15;
  const int MT = gM / 256, NTn = gN / 256, nk = gK / 32;
  unsigned char* sAb = smem;
  unsigned char* sBb = smem + 65536;
  const int drow = lane >> 2, dch = (lane & 3) ^ ((-((lane >> 4) & 3)) & 3);
  long offA[2], offB[2];
#pragma unroll
  for (int i = 0; i < 2; ++i) {
    const int row = (wave + 8 * i) * 16 + drow;
    offA[i] = (long)row * glda + dch * 8;
    const int sl = row & 127;
    const int src = (row & 128) + 32 * ((sl >> 2) & 3) + 4 * (sl >> 4) + (sl & 3);
    offB[i] = (long)src * gldb + dch * 8;
  }
  LAS unsigned char* lA = (LAS unsigned char*)sAb + wave * 1024;
  LAS unsigned char* lB = (LAS unsigned char*)sBb + wave * 1024;
#define G_DMA(pA_, pB_, buf, k0) { \
      _Pragma("unroll") for (int i_ = 0; i_ < 2; ++i_) __builtin_amdgcn_global_load_lds((const unsigned*)((pA_) + offA[i_] + (k0)), (LAS unsigned*)(lA + (buf) * 16384 + i_ * 8192), 16, 0, 0); \
      _Pragma("unroll") for (int i_ = 0; i_ < 2; ++i_) __builtin_amdgcn_global_load_lds((const unsigned*)((pB_) + offB[i_] + (k0)), (LAS unsigned*)(lB + (buf) * 16384 + i_ * 8192), 16, 0, 0); }
  const int nblk = GDIM(), xg = (nblk % 8 == 0) ? 8 : 1, xid = BIDX() % xg, jloc = BIDX() / xg, nloc_b = nblk / xg;
  const int per_mt = NTn * gnbatch, n_local = ((MT - xid + xg - 1) / xg) * per_mt;
#define G_TILE_DEC(l_, mt_, bt_, nt_) { const int mi_ = (l_) / per_mt, rem_ = (l_) % per_mt; mt_ = xid + xg * mi_; bt_ = rem_ / NTn; nt_ = rem_ % NTn; }
#define G_TILE_PTRS(l_, A_, B_) { int mt_, bt_, nt_; G_TILE_DEC(l_, mt_, bt_, nt_); \
      A_ = gA + (long)bt_ * gsA + (long)mt_ * 256 * glda; B_ = gBt + (long)bt_ * gsB + (long)nt_ * 256 * gldb; }
  const bool trail = wave >= 4;
  const bool stream = (gmode != 2);
  int cur = 0; bool started = false;
  for (int tile = jloc; tile < n_local; tile += nloc_b) {
    int mt, bt, nt; G_TILE_DEC(tile, mt, bt, nt);
    const bf16_t* A; const bf16_t* B; G_TILE_PTRS(tile, A, B);
    const bool has_next = stream && (tile + nloc_b < n_local);
    const bf16_t* An = A; const bf16_t* Bn = B;
    if (has_next) { G_TILE_PTRS(tile + nloc_b, An, Bn); }
    f32x4 acc[4][8];
#pragma unroll
    for (int i = 0; i < 4; ++i)
#pragma unroll
      for (int j = 0; j < 8; ++j) acc[i][j] = (f32x4){0.f, 0.f, 0.f, 0.f};
    if (!started) {
      cur = 0;
      G_DMA(A, B, 0, 0);
      G_DMA(A, B, 1, 32);
      G_DMA(A, B, 2, 64);
      asm volatile("s_waitcnt vmcnt(8)" ::: "memory");
      __builtin_amdgcn_s_barrier();
      if (trail) __builtin_amdgcn_s_barrier();
      started = stream;
    }
#pragma unroll 1
    for (int kt = 0; kt < nk; ++kt) {
      const int nx3 = (cur + 3) & 3;
      const bool more = (kt + 3 < nk) || has_next;
      if (kt + 3 < nk) { G_DMA(A, B, nx3, (kt + 3) * 32); }
      else if (has_next) { G_DMA(An, Bn, nx3, (kt + 3 - nk) * 32); }
      const int choff = ((g ^ ((-((c >> 2) & 3)) & 3)) << 4);
      const unsigned char* pa = sAb + cur * 16384 + (wm * 64 + c) * 64 + choff;
      const unsigned char* pb = sBb + cur * 16384 + (wn * 128 + c) * 64 + choff;
      bf16x8 af[4], bfr[8];
#pragma unroll
      for (int mi = 0; mi < 4; ++mi) af[mi] = *(const bf16x8*)(pa + mi * 16 * 64);
#pragma unroll
      for (int ni = 0; ni < 8; ++ni) bfr[ni] = *(const bf16x8*)(pb + ni * 16 * 64);
      if (more) { asm volatile("s_waitcnt vmcnt(8)" ::: "memory"); }
      else if (kt + 2 < nk) { asm volatile("s_waitcnt vmcnt(4)" ::: "memory"); }
      else { asm volatile("s_waitcnt vmcnt(0)" ::: "memory"); }
      asm volatile("s_waitcnt lgkmcnt(0)" ::: "memory");
      __builtin_amdgcn_sched_barrier(0);
      __builtin_amdgcn_s_barrier();
      __builtin_amdgcn_sched_barrier(0);
      __builtin_amdgcn_s_setprio(1);
#pragma unroll
      for (int mi = 0; mi < 4; ++mi)
#pragma unroll
        for (int ni = 0; ni < 8; ++ni) acc[mi][ni] = __builtin_amdgcn_mfma_f32_16x16x32_bf16(bfr[ni], af[mi], acc[mi][ni], 0, 0, 0);
      __builtin_amdgcn_s_setprio(0);
      __builtin_amdgcn_sched_barrier(0);
      __builtin_amdgcn_s_barrier();
      __builtin_amdgcn_sched_barrier(0);
      cur = (cur + 1) & 3;
    }
    if (!stream || !has_next) {
      if (!trail) __builtin_amdgcn_s_barrier();
      __syncthreads();
    }
    const int mloc = wm * 64 + c, nloc = wn * 128 + 32 * g;
    if (gmode == 0) {
      float* C = (float*)gC + (long)bt * gsC;
      const int n = nt * 256 + nloc;
#pragma unroll
      for (int mi = 0; mi < 4; ++mi) {
        const long m = (long)mt * 256 + mloc + mi * 16;
#pragma unroll
        for (int ni = 0; ni < 8; ++ni) {
          const float4 bv = gbias ? *(const float4*)(gbias + n + 4 * ni) : make_float4(0.f, 0.f, 0.f, 0.f);
          *(float4*)(C + m * gldc + n + 4 * ni) = make_float4(acc[mi][ni][0] + bv.x, acc[mi][ni][1] + bv.y, acc[mi][ni][2] + bv.z, acc[mi][ni][3] + bv.w);
        }
      }
    } else if (gmode == 1) {
      bf16_t* C = (bf16_t*)gC + (long)bt * gsC;
      const int n = nt * 256 + nloc;
#pragma unroll
      for (int mi = 0; mi < 4; ++mi) {
        const long m = (long)mt * 256 + mloc + mi * 16;
#pragma unroll
        for (int q = 0; q < 4; ++q) {
          const float4 b0 = gbias ? *(const float4*)(gbias + n + 8 * q) : make_float4(0.f, 0.f, 0.f, 0.f);
          const float4 b1 = gbias ? *(const float4*)(gbias + n + 8 * q + 4) : make_float4(0.f, 0.f, 0.f, 0.f);
          uint4 o;
          o.x = pack2(acc[mi][2 * q][0] + b0.x, acc[mi][2 * q][1] + b0.y); o.y = pack2(acc[mi][2 * q][2] + b0.z, acc[mi][2 * q][3] + b0.w);
          o.z = pack2(acc[mi][2 * q + 1][0] + b1.x, acc[mi][2 * q + 1][1] + b1.y); o.w = pack2(acc[mi][2 * q + 1][2] + b1.z, acc[mi][2 * q + 1][3] + b1.w);
          *(uint4*)(C + m * gldc + n + 8 * q) = o;
        }
      }
    } else {
      float* S = (float*)smem;
#pragma unroll 1
      for (int h = 0; h < 2; ++h) {
        if (wn == h) {
#pragma unroll
          for (int mi = 0; mi < 4; ++mi)
#pragma unroll
            for (int ni = 0; ni < 8; ++ni)
#pragma unroll
              for (int r = 0; r < 4; ++r) S[(mloc + mi * 16) * 129 + 32 * g + 4 * ni + r] = acc[mi][ni][r];
        }
        __syncthreads();
        if (tid < 256) {
          const float* row = S + tid * 129;
          unsigned best[16], cur16[16];
#pragma unroll
          for (int i = 0; i < 16; ++i) best[i] = (fkey(row[i]) & ~127u) | (unsigned)(127 - i);
          sort16_desc(best);
#pragma unroll
          for (int q = 1; q < 8; ++q) {
#pragma unroll
            for (int i = 0; i < 16; ++i) cur16[i] = (fkey(row[q * 16 + i]) & ~127u) | (unsigned)(127 - (q * 16 + i));
            sort16_desc(cur16);
            merge16_desc(best, cur16);
          }
          unsigned* dst = (unsigned*)gC + (((long)mt * 256 + tid) * (gN / 128) + (nt * 2 + h)) * 16;
#pragma unroll
          for (int i = 0; i < 4; ++i) *(uint4*)(dst + 4 * i) = make_uint4(best[4 * i], best[4 * i + 1], best[4 * i + 2], best[4 * i + 3]);
        }
        __syncthreads();
      }
    }
  }
#undef G_DMA
#undef G_TILE_PTRS
#undef G_TILE_DEC
}
DEV void mod_gemv(const Params& p, int skip_b) {
  const int bidx = BIDX() - skip_b, nblk = GDIM() - skip_b;
  if (bidx < 0) return;
  float* sc = (float*)smem;
  float* red = sc + 3 * 1024;
  const int tid = TIDX();
  for (int i = tid; i < 3072; i += NT) {
    const int r = i >> 10, k = i & 1023;
    const float v = (r < 2) ? PIN(I_C)[r * 1024 + k] : PIN(I_CCTX)[k];
    sc[i] = silu_f(v);
  }
  __syncthreads();
  float* MOD = (float*)(PWS() + OFF_MOD);
  const int col = tid & 31, ks = tid >> 5;
  for (int item = bidx; item < 4 * 192; item += nblk) {
    const int layer = item / 192, n0 = (item % 192) * 32;
    const float* W = PIN(I_ADAW) + (size_t)layer * 1024 * 6144 + n0 + col;
    float a0 = 0.f, a1 = 0.f, a2 = 0.f;
#pragma unroll 8
    for (int kk = 0; kk < 64; ++kk) {
      const int k = ks * 64 + kk;
      const float w = W[(size_t)k * 6144];
      a0 += sc[k] * w; a1 += sc[1024 + k] * w; a2 += sc[2048 + k] * w;
    }
    red[(ks * 3 + 0) * 32 + col] = a0; red[(ks * 3 + 1) * 32 + col] = a1; red[(ks * 3 + 2) * 32 + col] = a2;
    __syncthreads();
    if (tid < 96) {
      const int r = tid >> 5, cc = tid & 31;
      float s = PIN(I_ADAB)[layer * 6144 + n0 + cc];
#pragma unroll
      for (int q = 0; q < 16; ++q) s += red[(q * 3 + r) * 32 + cc];
      MOD[(size_t)(layer * 3 + r) * 6144 + n0 + cc] = s;
    }
    __syncthreads();
  }
}

DEV void wconv_tile(const Params& p, const float* src, int ld, int K, bf16_t* dst, int kt, int ntile) {
  float* tl = (float*)smem;
  const int tid = TIDX();
  {
    const int r = tid >> 4, c4 = (tid & 15) * 4;
#pragma unroll
    for (int h = 0; h < 2; ++h) {
      const int rr = r + 32 * h;
      const float4 v = *(const float4*)(src + (size_t)(kt * 64 + rr) * ld + ntile * 64 + c4);
      tl[rr * 65 + c4] = v.x; tl[rr * 65 + c4 + 1] = v.y; tl[rr * 65 + c4 + 2] = v.z; tl[rr * 65 + c4 + 3] = v.w;
    }
  }
  __syncthreads();
  {
    const int n = tid >> 3, k8 = (tid & 7) * 8;
    uint4 o;
    o.x = pack2(tl[(k8 + 0) * 65 + n], tl[(k8 + 1) * 65 + n]); o.y = pack2(tl[(k8 + 2) * 65 + n], tl[(k8 + 3) * 65 + n]);
    o.z = pack2(tl[(k8 + 4) * 65 + n], tl[(k8 + 5) * 65 + n]); o.w = pack2(tl[(k8 + 6) * 65 + n], tl[(k8 + 7) * 65 + n]);
    *(uint4*)(dst + (size_t)(ntile * 64 + n) * K + kt * 64 + k8) = o;
  }
  __syncthreads();
}

DEV void weight_convert(const Params& p, int skip_b) {
  const int bidx = BIDX() - skip_b, nblk = GDIM() - skip_b;
  if (bidx < 0) return;
  const int total = (48 + 48 + 16 + 16 + 64 + 16 + 16) * 16;
  for (int item = bidx; item < total; item += nblk) {
    int m, rem;
    if (item < 768) { m = 0; rem = item; }
    else if (item < 1536) { m = 1; rem = item - 768; }
    else if (item < 1792) { m = 2; rem = item - 1536; }
    else if (item < 2048) { m = 3; rem = item - 1792; }
    else if (item < 3072) { m = 4; rem = item - 2048; }
    else if (item < 3328) { m = 5; rem = item - 3072; }
    else { m = 6; rem = item - 3328; }
    const int kt = rem & 15, ntile = rem >> 4;
    const float* src; int ld; bf16_t* dst;
    switch (m) {
      case 0: case 1: src = PIN(I_HYINW) + (size_t)m * 1024 * 3072; ld = 3072; dst = (bf16_t*)(PWS() + OFF_W_HYIN) + (size_t)m * 3072 * 1024; break;
      case 2: case 3: src = PIN(I_HYOUTW) + (size_t)(m - 2) * 1024 * 1024; ld = 1024; dst = (bf16_t*)(PWS() + OFF_W_HYOUT) + (size_t)(m - 2) * 1024 * 1024; break;
      case 4: src = PIN(I_GDINW); ld = 4128; dst = (bf16_t*)(PWS() + OFF_W_GDIN); break;
      case 5: src = PIN(I_GDOUTW); ld = 1024; dst = (bf16_t*)(PWS() + OFF_W_GDOUT); break;
      default: src = PIN(I_FNOUTW); ld = 1024; dst = (bf16_t*)(PWS() + OFF_W_FNOUT); break;
    }
    wconv_tile(p, src, ld, 1024, dst, kt, ntile);
  }
  const size_t gtid = (size_t)bidx * NT + TIDX(), gsz = (size_t)nblk * NT;
  bf16_t* wab = (bf16_t*)(PWS() + OFF_W_GDAB);
  for (size_t i = gtid; i < (size_t)256 * 1024; i += gsz) {
    const int n = (int)(i >> 10), k = (int)(i & 1023);
    wab[i] = (n < 32) ? f2bf(PIN(I_GDINW)[(size_t)k * 4128 + 4096 + n]) : (bf16_t)0;
  }
  float* pe = (float*)(PWS() + OFF_PE);
  for (size_t i = gtid; i < (size_t)320 * 512; i += gsz) {
    const int r = (int)(i >> 9), dd = (int)(i & 511), jj = dd & 255;
    const float om = expf(-(float)jj * (9.210340371976184f / 256.f));
    const float a = (float)(r < 256 ? r : r - 256) * om;
    pe[i] = (dd >> 8) ? cosf(a) : sinf(a);
  }
  bf16_t* wd = (bf16_t*)(PWS() + OFF_W_DFT);
  for (size_t i = gtid; i < (size_t)256 * 256; i += gsz) {
    const int n = (int)(i >> 8), cc = (int)(i & 255), m = n >> 1, s = n & 1;
    float v;
    if (m == 0) v = s ? ((cc & 1) ? -1.f : 1.f) : 1.f;
    else { const float fr = (float)((cc * m) & 255) * (1.f / 256.f); v = s ? -__builtin_amdgcn_sinf(fr) : __builtin_amdgcn_cosf(fr); }
    wd[i] = f2bf(v);
  }
}

DEV void fold_wqk(const Params& p) {
  float* Ks = (float*)smem;
  float* Ws = Ks + 128 * 129;
  const int tid = TIDX();
  for (int item = BIDX(); item < 4 * 16 * 8; item += GDIM()) {
    const int l = item >> 7, hp = (item >> 3) & 15, ntile = item & 7;
    const float* keys = PIN(I_PKKEYS) + ((size_t)(l * 16 + hp) * 128) * 128;
    const float* wq = PIN(I_PKWQ) + (size_t)l * 1024 * 2048 + (size_t)(ntile * 128) * 2048 + hp * 128;
    for (int i = tid; i < 128 * 32; i += NT) {
      const int r = i >> 5, c4 = (i & 31) * 4;
      const float4 a = *(const float4*)(keys + (size_t)r * 128 + c4);
      Ks[r * 129 + c4] = a.x; Ks[r * 129 + c4 + 1] = a.y; Ks[r * 129 + c4 + 2] = a.z; Ks[r * 129 + c4 + 3] = a.w;
      const float4 b = *(const float4*)(wq + (size_t)r * 2048 + c4);
      Ws[r * 129 + c4] = b.x; Ws[r * 129 + c4 + 1] = b.y; Ws[r * 129 + c4 + 2] = b.z; Ws[r * 129 + c4 + 3] = b.w;
    }
    __syncthreads();
    const int ty = tid >> 4, tx = tid & 15;
    float acc[4][8];
#pragma unroll
    for (int i = 0; i < 4; ++i)
#pragma unroll
      for (int j = 0; j < 8; ++j) acc[i][j] = 0.f;
    for (int d = 0; d < 128; ++d) {
      float a[4], b[8];
#pragma unroll
      for (int i = 0; i < 4; ++i) a[i] = Ks[(ty * 4 + i) * 129 + d];
#pragma unroll
      for (int j = 0; j < 8; ++j) b[j] = Ws[(tx * 8 + j) * 129 + d];
#pragma unroll
      for (int i = 0; i < 4; ++i)
#pragma unroll
        for (int j = 0; j < 8; ++j) acc[i][j] += a[i] * b[j];
    }
    bf16_t* dst = (bf16_t*)(PWS() + OFF_WQK) + (size_t)l * 2048 * 1024;
#pragma unroll
    for (int i = 0; i < 4; ++i) {
      uint4 o; o.x = pack2(acc[i][0], acc[i][1]); o.y = pack2(acc[i][2], acc[i][3]); o.z = pack2(acc[i][4], acc[i][5]); o.w = pack2(acc[i][6], acc[i][7]);
      *(uint4*)(dst + (size_t)(hp * 128 + ty * 4 + i) * 1024 + ntile * 128 + tx * 8) = o;
    }
    __syncthreads();
  }
}

DEV float sin_hw(float x) { const float r = x * 0.15915494309189535f; return __builtin_amdgcn_sinf(r - floorf(r)); }
DEV void hyena_filter(const Params& p, int j, bool with_ctx) {
  float* feat = (float*)smem;
  float* h1 = feat + 64 * 33;
  float* h2t = h1 + 64 * 64;
  const int tid = TIDX();
  const float* W1 = PIN(I_HYFW1) + (size_t)j * 33 * 64; const float* B1 = PIN(I_HYFB1) + j * 64;
  const float* W2 = PIN(I_HYFW2) + (size_t)j * 64 * 64; const float* B2 = PIN(I_HYFB2) + j * 64;
  const float* W3 = PIN(I_HYFW3) + (size_t)j * 64 * 2048;
  const int nitems = 256 + (with_ctx ? 4 : 0);
  for (int item = BIDX(); item < nitems; item += GDIM()) {
    const bool isctx = item >= 256;
    const int Ls = isctx ? 256 : 16384;
    const int n0 = (isctx ? item - 256 : item) * 64;
    float* FW = (float*)(PWS() + OFF_FILT) + (isctx ? (size_t)2 * 1024 * 16384 : 0);
    float* BW = FW + (size_t)1024 * Ls;
    const float invL = 1.f / (float)Ls;
    int tq = TIDX(); asm volatile("" : "+v"(tq));
    {
      const int pp = tq >> 3, fg = tq & 7;
      const float t = (float)(n0 + pp) * invL;
#pragma unroll
      for (int i = 0; i < 5; ++i) {
        const int f = fg + 8 * i;
        if (f < 33) {
          float v;
          if (f == 0) v = t;
          else {
            const int jb = (f - 1) & 15;
            const float band = 1e-4f + (float)jb * ((15.f - 1e-4f) / 15.f);
            const float rev = t * band;
            v = (f <= 16) ? __builtin_amdgcn_cosf(rev) : -__builtin_amdgcn_sinf(rev);
          }
          feat[pp * 33 + f] = v;
        }
      }
    }
    __syncthreads();
    {
      const int pp = tq >> 3, o0 = (tq & 7) * 8;
      float a[8];
#pragma unroll
      for (int i = 0; i < 8; ++i) a[i] = B1[o0 + i];
      for (int f = 0; f < 33; ++f) {
        const float x = feat[pp * 33 + f];
#pragma unroll
        for (int i = 0; i < 8; ++i) a[i] += x * W1[f * 64 + o0 + i];
      }
#pragma unroll
      for (int i = 0; i < 8; ++i) h1[pp * 64 + o0 + i] = sin_hw(a[i]);
    }
    __syncthreads();
    {
      const int pp = tq >> 3, o0 = (tq & 7) * 8;
      float a[8];
#pragma unroll
      for (int i = 0; i < 8; ++i) a[i] = B2[o0 + i];
      for (int f = 0; f < 64; ++f) {
        const float x = h1[pp * 64 + f];
#pragma unroll
        for (int i = 0; i < 8; ++i) a[i] += x * W2[f * 64 + o0 + i];
      }
#pragma unroll
      for (int i = 0; i < 8; ++i) h2t[(o0 + i) * 64 + pp] = sin_hw(a[i]);
    }
    __syncthreads();
#pragma unroll 1
    for (int cs = 0; cs < 4; ++cs) {
      const int c2 = cs * 512 + tq;
      float acc[64];
#pragma unroll
      for (int n = 0; n < 64; ++n) acc[n] = 0.f;
#pragma unroll 1
      for (int kq = 0; kq < 4; ++kq) {
        float wv[16];
#pragma unroll
        for (int i = 0; i < 16; ++i) wv[i] = W3[(size_t)(kq * 16 + i) * 2048 + c2];
#pragma unroll
        for (int i = 0; i < 16; ++i) {
          const int kk = kq * 16 + i;
#pragma unroll
          for (int n4 = 0; n4 < 16; ++n4) {
            const float4 hv = *(const float4*)(h2t + kk * 64 + n4 * 4);
            acc[n4 * 4] += hv.x * wv[i]; acc[n4 * 4 + 1] += hv.y * wv[i]; acc[n4 * 4 + 2] += hv.z * wv[i]; acc[n4 * 4 + 3] += hv.w * wv[i];
          }
        }
      }
      const int cch = c2 & 1023;
      const float dmin = 3.0701134573253946f, dmax = 15.350567286626973f;
      const float delta = dmin + (dmax - dmin) * ((float)cch * (1.f / 1023.f));
      float* dst = ((c2 >> 10) ? BW : FW) + (size_t)cch * Ls + n0;
#pragma unroll
      for (int n4 = 0; n4 < 16; ++n4) {
        float4 o;
        o.x = acc[n4 * 4] * (__expf(-(float)(n0 + n4 * 4) * invL * delta) + 0.05f);
        o.y = acc[n4 * 4 + 1] * (__expf(-(float)(n0 + n4 * 4 + 1) * invL * delta) + 0.05f);
        o.z = acc[n4 * 4 + 2] * (__expf(-(float)(n0 + n4 * 4 + 2) * invL * delta) + 0.05f);
        o.w = acc[n4 * 4 + 3] * (__expf(-(float)(n0 + n4 * 4 + 3) * invL * delta) + 0.05f);
        *(float4*)(dst + n4 * 4) = o;
        if ((n4 & 3) == 3) __builtin_amdgcn_sched_barrier(0);
      }
    }
    __syncthreads();
  }
}

DEV void init_phase(const Params& p) {
  const int tid = TIDX(), lane = tid & 63, wave = tid >> 6;
  bf16_t* X = (bf16_t*)(PWS() + OFF_X);
  bf16_t* H = (bf16_t*)(PWS() + OFF_H);
  const float* MOD = (const float*)(PWS() + OFF_MOD);
  for (int row = BIDX() * 8 + wave; row < TT; row += GDIM() * 8) {
    float v[16];
    if (row < TL) {
      load16f(PIN(I_X) + (size_t)row * 1024 + lane * 16, v);
      const int t = row & 16383, gr = t >> 6, gc = t & 63;
      float pv[16];
      load16f((const float*)(PWS() + OFF_PE) + (size_t)(lane < 32 ? gr : 256 + gc) * 512 + (lane & 31) * 16, pv);
#pragma unroll
      for (int i = 0; i < 16; ++i) v[i] += pv[i];
    } else {
      load16f(PIN(I_CTX) + (size_t)(row - TL) * 1024 + lane * 16, v);
    }
    store16bf(X + (size_t)row * 1024 + lane * 16, v);
    const int mr = modrow_of(row);
    float sh[16], scl[16];
    load16f(mod_ptr(MOD, 0, mr, 0) + lane * 16, sh); load16f(mod_ptr(MOD, 0, mr, 1) + lane * 16, scl);
#pragma unroll
    for (int i = 0; i < 16; ++i) v[i] = v[i] * (1.f + scl[i]) + sh[i];
    store16bf(H + (size_t)row * 1024 + lane * 16, v);
  }
}
__device__ constexpr float C32[16] = {1.f, 0.98078528040323043f, 0.92387953251128674f, 0.83146961230254524f, 0.70710678118654752f, 0.55557023301960218f, 0.38268343236508977f, 0.19509032201612825f,
                                      0.f, -0.19509032201612825f, -0.38268343236508977f, -0.55557023301960218f, -0.70710678118654752f, -0.83146961230254524f, -0.92387953251128674f, -0.98078528040323043f};
__device__ constexpr float S32[16] = {0.f, 0.19509032201612825f, 0.38268343236508977f, 0.55557023301960218f, 0.70710678118654752f, 0.83146961230254524f, 0.92387953251128674f, 0.98078528040323043f,
                                      1.f, 0.98078528040323043f, 0.92387953251128674f, 0.83146961230254524f, 0.70710678118654752f, 0.55557023301960218f, 0.38268343236508977f, 0.19509032201612825f};
DEV float2 cmul(float2 a, float2 b) { return make_float2(a.x * b.x - a.y * b.y, a.x * b.y + a.y * b.x); }
DEV float2 cmulc(float2 a, float2 b) { return make_float2(a.x * b.x + a.y * b.y, a.y * b.x - a.x * b.y); }
constexpr int brev_c(int i, int bits) { int r = 0; for (int b = 0; b < bits; ++b) r |= ((i >> b) & 1) << (bits - 1 - b); return r; }

template <int R> DEV void fft_dif(float2 (&v)[R]) {
#pragma unroll
  for (int n = R; n >= 2; n >>= 1) {
    const int h = n >> 1;
#pragma unroll
    for (int base = 0; base < R; base += n) {
#pragma unroll
      for (int j = 0; j < h; ++j) {
        const float2 a = v[base + j], b = v[base + j + h];
        v[base + j] = make_float2(a.x + b.x, a.y + b.y);
        const float2 d = make_float2(a.x - b.x, a.y - b.y);
        const int m = j * (32 / n);
        if (m == 0) v[base + j + h] = d;
        else if (m == 8) v[base + j + h] = make_float2(d.y, -d.x);
        else v[base + j + h] = make_float2(d.x * C32[m] + d.y * S32[m], d.y * C32[m] - d.x * S32[m]);
      }
    }
    __builtin_amdgcn_sched_barrier(0);
  }
}
template <int R> DEV void ifft_dit(float2 (&v)[R]) {
#pragma unroll
  for (int n = 2; n <= R; n <<= 1) {
    const int h = n >> 1;
#pragma unroll
    for (int base = 0; base < R; base += n) {
#pragma unroll
      for (int j = 0; j < h; ++j) {
        const float2 a = v[base + j], b0 = v[base + j + h];
        const int m = j * (32 / n);
        float2 b;
        if (m == 0) b = b0;
        else if (m == 8) b = make_float2(-b0.y, b0.x);
        else b = make_float2(b0.x * C32[m] - b0.y * S32[m], b0.y * C32[m] + b0.x * S32[m]);
        v[base + j] = make_float2(a.x + b.x, a.y + b.y);
        v[base + j + h] = make_float2(a.x - b.x, a.y - b.y);
      }
    }
    __builtin_amdgcn_sched_barrier(0);
  }
}
DEV int amap(int pidx) { return pidx + (pidx >> 4) + (pidx >> 9); }
DEV float2 twid(int num, float inv_den) {
  const float fr = (float)num * inv_den;
  return make_float2(__builtin_amdgcn_cosf(fr), -__builtin_amdgcn_sinf(fr));
}

struct TwGen { float2 w1, w2, w4, w8, w16, w24, A; };
DEV void tw_init(TwGen& g, int num, float inv_den) {
  g.w1 = twid(num, inv_den); g.w2 = cmul(g.w1, g.w1); g.w4 = cmul(g.w2, g.w2); g.w8 = cmul(g.w4, g.w4); g.w16 = cmul(g.w8, g.w8); g.w24 = cmul(g.w8, g.w16);
  g.A = make_float2(1.f, 0.f);
}
DEV float2 tw_get(TwGen& g, int i) {
  const int blk = i >> 2, sub = i & 3;
  if (sub == 0) {
    if (blk == 0) g.A = make_float2(1.f, 0.f);
    else if (blk == 1) g.A = g.w4;
    else if (blk == 2) g.A = g.w2;
    else if (blk == 3) g.A = cmul(g.w2, g.w4);
    else if (blk == 4) g.A = g.w1;
    else if (blk == 5) g.A = cmul(g.w1, g.w4);
    else if (blk == 6) g.A = cmul(g.w1, g.w2);
    else g.A = cmul(cmul(g.w1, g.w2), g.w4);
    return g.A;
  }
  const float2 m = sub == 1 ? g.w16 : (sub == 2 ? g.w8 : g.w24);
  return blk == 0 ? m : cmul(g.A, m);
}
__device__ constexpr float C64[32] = {1.0f, 0.99518472667219693f, 0.98078528040323043f, 0.95694033573220882f, 0.92387953251128674f, 0.88192126434835505f, 0.83146961230254524f, 0.77301045336273699f, 0.70710678118654757f, 0.63439328416364549f, 0.55557023301960229f, 0.47139673682599781f, 0.38268343236508984f, 0.29028467725446233f, 0.19509032201612833f, 0.09801714032956077f, 6.123233995736766e-17f, -0.098017140329560645f, -0.19509032201612819f, -0.29028467725446216f, -0.38268343236508973f, -0.4713967368259977f, -0.55557023301960196f, -0.63439328416364538f, -0.70710678118654746f, -0.77301045336273699f, -0.83146961230254535f, -0.88192126434835494f, -0.92387953251128674f, -0.95694033573220882f, -0.98078528040323043f, -0.99518472667219682f};
__device__ constexpr float S64[32] = {0.0f, 0.098017140329560604f, 0.19509032201612825f, 0.29028467725446233f, 0.38268343236508978f, 0.47139673682599764f, 0.55557023301960218f, 0.63439328416364549f, 0.70710678118654746f, 0.77301045336273699f, 0.83146961230254524f, 0.88192126434835494f, 0.92387953251128674f, 0.95694033573220894f, 0.98078528040323043f, 0.99518472667219682f, 1.0f, 0.99518472667219693f, 0.98078528040323043f, 0.95694033573220894f, 0.92387953251128674f, 0.88192126434835505f, 0.83146961230254546f, 0.7730104533627371f, 0.70710678118654757f, 0.63439328416364549f, 0.55557023301960218f, 0.47139673682599786f, 0.38268343236508989f, 0.29028467725446239f, 0.19509032201612861f, 0.098017140329560826f};
DEV float2 tw_odd(float2 w0, int i) { return make_float2(w0.x * C64[i] + w0.y * S64[i], w0.y * C64[i] - w0.x * S64[i]); }

#define SB() __builtin_amdgcn_sched_barrier(0)
DEV void fft_fwd_pass1_store(float2 (&v)[32], float2* cx, int tid) {
  asm volatile("" : "+v"(tid));
  SB();
  fft_dif<32>(v);
  float2* base = cx + tid + (tid >> 4);
  TwGen g; tw_init(g, tid, 1.f / 16384.f);
#pragma unroll
  for (int i = 0; i < 32; ++i) {
    const int k1 = brev_c(i, 5);
    const float2 t = tw_get(g, i);
    base[k1 * 545] = cmul(v[i], t);
    if ((i & 3) == 3) SB();
  }
}
DEV void fft_fwd_pass2(float2* cx, int tid) {
  asm volatile("" : "+v"(tid));
  const int k1 = ((tid >> 4) & 1) * 16 + (tid >> 5), n00 = tid & 15;
  float2 v[32];
  float2* base = cx + k1 * 545 + n00;
#pragma unroll
  for (int i = 0; i < 32; ++i) v[i] = base[i * 17];
  SB();
  fft_dif<32>(v);
  TwGen g; tw_init(g, n00, 1.f / 512.f);
#pragma unroll
  for (int i = 0; i < 32; ++i) {
    const int k01 = brev_c(i, 5);
    const float2 t = tw_get(g, i);
    base[k01 * 17] = cmul(v[i], t);
    if ((i & 3) == 3) SB();
  }
}
DEV void fft_fwd_pass3_regs(const float2* cx, int tid, float2 (&w0)[16], float2 (&w1)[16]) {
  asm volatile("" : "+v"(tid));
  const float2* b0 = cx + tid * 17 + (tid >> 5);
  const float2* b1 = cx + (tid + 512) * 17 + ((tid + 512) >> 5);
#pragma unroll
  for (int i = 0; i < 16; ++i) { w0[i] = b0[i]; w1[i] = b1[i]; }
  SB();
  fft_dif<16>(w0); SB(); fft_dif<16>(w1); SB();
}
DEV void fft_inv_pass3_store(float2 (&w0)[16], float2 (&w1)[16], float2* cx, int tid) {
  asm volatile("" : "+v"(tid));
  SB(); ifft_dit<16>(w0); SB(); ifft_dit<16>(w1); SB();
  float2* b0 = cx + tid * 17 + (tid >> 5);
  float2* b1 = cx + (tid + 512) * 17 + ((tid + 512) >> 5);
#pragma unroll
  for (int i = 0; i < 16; ++i) { b0[i] = w0[i]; b1[i] = w1[i]; }
}
DEV void fft_inv_pass2(float2* cx, int tid) {
  asm volatile("" : "+v"(tid));
  const int k1 = ((tid >> 4) & 1) * 16 + (tid >> 5), n00 = tid & 15;
  float2 v[32];
  float2* base = cx + k1 * 545 + n00;
  TwGen g; tw_init(g, n00, 1.f / 512.f);
#pragma unroll
  for (int i = 0; i < 32; ++i) {
    const int k01 = brev_c(i, 5);
    const float2 t = tw_get(g, i);
    v[i] = cmulc(base[k01 * 17], t);
    if ((i & 3) == 3) SB();
  }
  ifft_dit<32>(v);
  SB();
#pragma unroll
  for (int i = 0; i < 32; ++i) base[i * 17] = v[i];
}
DEV void fft_inv_pass1_regs(const float2* cx, int tid, float2 (&v)[32]) {
  asm volatile("" : "+v"(tid));
  const float2* base = cx + tid + (tid >> 4);
  TwGen g; tw_init(g, tid, 1.f / 16384.f);
#pragma unroll
  for (int i = 0; i < 32; ++i) {
    const int k1 = brev_c(i, 5);
    const float2 t = tw_get(g, i);
    v[i] = cmulc(base[k1 * 545], t);
    if ((i & 3) == 3) SB();
  }
  ifft_dit<32>(v);
  SB();
}

DEV int seg_row0(int seg) { return seg < 2 ? seg * LSEQ : TL + (seg - 2) * CTXL; }
DEV int seg_len(int seg) { return seg < 2 ? LSEQ : CTXL; }
DEV size_t cm_off(int seg, int ch) { return seg < 2 ? ((size_t)(seg * 1024 + ch) * LSEQ) : ((size_t)2 * 1024 * LSEQ + (size_t)((seg - 2) * 1024 + ch) * CTXL); }

DEV void hy_prep(const Params& p, int j, bool with_ctx) {
  const bf16_t* U = (const bf16_t*)(PWS() + OFF_RA);
  bf16_t* X0 = (bf16_t*)(PWS() + OFF_RB);
  float* ZT = (float*)(PWS() + OFF_RB + (size_t)TT * D * 2);
  const float* CW = PIN(I_HYCONV) + (size_t)j * 3 * 3072;
  float* zt = (float*)smem;
  const int tid = TIDX();
  const int nlat = 2 * 256 * 16, nitems = nlat + (with_ctx ? 2 * 4 * 16 : 0);
  for (int item = BIDX(); item < nitems; item += GDIM()) {
    int seg, tt, ct;
    if (item < nlat) { seg = item >> 12; tt = (item >> 4) & 255; ct = item & 15; }
    else { const int r = item - nlat; seg = 2 + (r >> 6); tt = (r >> 4) & 3; ct = r & 15; }
    const int Ls = seg_len(seg), row0 = seg_row0(seg), t0 = tt * 64, c0 = ct * 64;
    {
      const int tl = tid >> 3, cg = tid & 7, t = t0 + tl, cc = c0 + cg * 8;
      float o[3][8];
#pragma unroll
      for (int s = 0; s < 3; ++s) {
#pragma unroll
        for (int i = 0; i < 8; ++i) o[s][i] = 0.f;
#pragma unroll
        for (int dt = 0; dt < 3; ++dt) {
          const int ts = t + dt - 1;
          if (ts >= 0 && ts < Ls) {
            const uint4 u = *(const uint4*)(U + (size_t)(row0 + ts) * 3072 + s * 1024 + cc);
            const float4 w0 = *(const float4*)(CW + dt * 3072 + s * 1024 + cc), w1 = *(const float4*)(CW + dt * 3072 + s * 1024 + cc + 4);
            o[s][0] += bflo(u.x) * w0.x; o[s][1] += bfhi(u.x) * w0.y; o[s][2] += bflo(u.y) * w0.z; o[s][3] += bfhi(u.y) * w0.w;
            o[s][4] += bflo(u.z) * w1.x; o[s][5] += bfhi(u.z) * w1.y; o[s][6] += bflo(u.w) * w1.z; o[s][7] += bfhi(u.w) * w1.w;
          }
        }
      }
      uint4 xo; xo.x = pack2(o[0][0], o[0][1]); xo.y = pack2(o[0][2], o[0][3]); xo.z = pack2(o[0][4], o[0][5]); xo.w = pack2(o[0][6], o[0][7]);
      *(uint4*)(X0 + (size_t)(row0 + t) * 1024 + cc) = xo;
#pragma unroll
      for (int i = 0; i < 8; ++i) zt[(cg * 8 + i) * 65 + tl] = o[2][i] * o[1][i];
    }
    __syncthreads();
    {
      const int cl = tid >> 3, tq = (tid & 7) * 8;
      float* dst = ZT + cm_off(seg, c0 + cl) + t0 + tq;
      *(float4*)dst = make_float4(zt[cl * 65 + tq], zt[cl * 65 + tq + 1], zt[cl * 65 + tq + 2], zt[cl * 65 + tq + 3]);
      *(float4*)(dst + 4) = make_float4(zt[cl * 65 + tq + 4], zt[cl * 65 + tq + 5], zt[cl * 65 + tq + 6], zt[cl * 65 + tq + 7]);
    }
    __syncthreads();
  }
}

DEV void hy_fft(const Params& p, int j, bool with_ctx) {
  const float* ZT = (const float*)(PWS() + OFF_RB + (size_t)TT * D * 2);
  float* YT = (float*)(PWS() + OFF_RA);
  const float* FW = (const float*)(PWS() + OFF_FILT);
  const float* BW = FW + (size_t)1024 * LSEQ;
  const float* SKIP = PIN(I_HYSKIP) + j * 1024;
  float2* cx = (float2*)smem;
  const int tid = TIDX();
  float2* spec = (float2*)(PWS() + OFF_RC) + (size_t)BIDX() * 16384;
  for (int ch = BIDX(); ch < 1024; ch += GDIM()) {
    const float* z0 = ZT + cm_off(0, ch); const float* z1 = ZT + cm_off(1, ch);
    float* y0 = YT + cm_off(0, ch); float* y1 = YT + cm_off(1, ch);
    const float* fw = FW + (size_t)ch * LSEQ; const float* bw = BW + (size_t)ch * LSEQ;
    const float skip = SKIP[ch];
#pragma unroll 1
    for (int odd = 0; odd < 2; ++odd) {
      {
        float2 v[32];
        int tq = tid; asm volatile("" : "+v"(tq));
        const float2 wo = twid(tq, 1.f / 32768.f);
#pragma unroll
        for (int i = 0; i < 32; ++i) {
          const int n = i * 512 + tq;
          const float hf = fw[n] + (n == 0 ? skip : 0.f), hb = (n > 0) ? bw[LSEQ - n] : 0.f;
          if (odd) { const float2 t = tw_odd(wo, i); const float d = hf - hb; v[i] = make_float2(d * t.x, d * t.y); }
          else v[i] = make_float2(hf + hb, 0.f);
          if ((i & 15) == 15) SB();
        }
        fft_fwd_pass1_store(v, cx, tid);
      }
      __syncthreads();
      fft_fwd_pass2(cx, tid);
      __syncthreads();
      {
        float2 f0[16], f1[16];
        fft_fwd_pass3_regs(cx, tid, f0, f1);
        float2* sp = spec + tid; asm volatile("" : "+v"(sp));
#pragma unroll
        for (int i = 0; i < 16; ++i) { sp[i * 512] = f0[i]; sp[(16 + i) * 512] = f1[i]; }
      }
      __syncthreads();
      {
        float2 v[32];
        int tq = tid; asm volatile("" : "+v"(tq));
        const float2 wo = twid(tq, 1.f / 32768.f);
#pragma unroll
        for (int i = 0; i < 32; ++i) {
          const int n = i * 512 + tq;
          const float2 w = make_float2(z0[n], z1[n]);
          v[i] = odd ? cmul(w, tw_odd(wo, i)) : w;
          if ((i & 15) == 15) SB();
        }
        fft_fwd_pass1_store(v, cx, tid);
      }
      __syncthreads();
      fft_fwd_pass2(cx, tid);
      __syncthreads();
      {
        float2 w0[16], w1[16];
        fft_fwd_pass3_regs(cx, tid, w0, w1);
        const float2* sp = spec + tid; asm volatile("" : "+v"(sp));
#pragma unroll
        for (int i = 0; i < 16; ++i) { w0[i] = cmul(w0[i], sp[i * 512]); w1[i] = cmul(w1[i], sp[(16 + i) * 512]); }
        fft_inv_pass3_store(w0, w1, cx, tid);
      }
      __syncthreads();
      fft_inv_pass2(cx, tid);
      __syncthreads();
      {
        float2 v[32];
        fft_inv_pass1_regs(cx, tid, v);
        const float sc = 0.5f / 16384.f;
        int tq = tid; asm volatile("" : "+v"(tq));
        const float2 wo = twid(tq, 1.f / 32768.f);
#pragma unroll
        for (int i = 0; i < 32; ++i) {
          const int n = i * 512 + tq;
          if (!odd) { y0[n] = sc * v[i].x; y1[n] = sc * v[i].y; }
          else { const float2 r = cmulc(v[i], tw_odd(wo, i)); y0[n] += sc * r.x; y1[n] += sc * r.y; }
          if ((i & 15) == 15) SB();
        }
      }
      __syncthreads();
    }
  }
  if (with_ctx) {
    const float* FWc = FW + (size_t)2 * 1024 * LSEQ; const float* BWc = FWc + (size_t)1024 * CTXL;
    float* zs = (float*)smem; float* fs = zs + 8 * 256; float* bs = fs + 8 * 256;
    for (int item = BIDX(); item < 256; item += GDIM()) {
      const int b = item >> 7, c0 = (item & 127) * 8;
      for (int i = tid; i < 2048; i += NT) {
        const int cl = i >> 8, t = i & 255;
        zs[i] = ZT[cm_off(2 + b, c0 + cl) + t]; fs[i] = FWc[(size_t)(c0 + cl) * CTXL + t]; bs[i] = BWc[(size_t)(c0 + cl) * CTXL + t];
      }
      __syncthreads();
      for (int i = tid; i < 2048; i += NT) {
        const int cl = i >> 8, t = i & 255;
        float a = 0.f;
        for (int s = 0; s <= t; ++s) a += fs[cl * 256 + t - s] * zs[cl * 256 + s];
        for (int s = t + 1; s < 256; ++s) a += bs[cl * 256 + s - t] * zs[cl * 256 + s];
        YT[cm_off(2 + b, c0 + cl) + t] = a + SKIP[c0 + cl] * zs[i];
      }
      __syncthreads();
    }
  }
}

DEV void cm_to_tok(const Params& p, const float* src, const bf16_t* mul, bf16_t* dst, bool with_ctx) {
  float* tlb = (float*)smem;
  const int tid = TIDX();
  const int nlat = 2 * 64 * 16, nitems = nlat + (with_ctx ? 2 * 16 : 0);
  for (int item = BIDX(); item < nitems; item += GDIM()) {
    int seg, tt, ct;
    if (item < nlat) { seg = item >> 10; tt = (item >> 4) & 63; ct = item & 15; }
    else { const int r = item - nlat; seg = 2 + (r >> 4); tt = 0; ct = r & 15; }
    const int row0 = seg_row0(seg), t0 = tt * 256, c0 = ct * 64;
    {
      const int cl = tid >> 3, tq = tid & 7;
      const float* s = src + cm_off(seg, c0 + cl) + t0;
      float4 v[8];
#pragma unroll
      for (int j = 0; j < 8; ++j) v[j] = *(const float4*)(s + (tq + 8 * j) * 4);
#pragma unroll
      for (int j = 0; j < 8; ++j) { float* d = tlb + cl * 257 + (tq + 8 * j) * 4; d[0] = v[j].x; d[1] = v[j].y; d[2] = v[j].z; d[3] = v[j].w; }
    }
    __syncthreads();
    {
      const int tl = tid >> 1, cg = (tid & 1) * 32;
      const size_t o = (size_t)(row0 + t0 + tl) * 1024 + c0 + cg;
      uint4 m[4];
      if (mul) {
#pragma unroll
        for (int q = 0; q < 4; ++q) m[q] = *(const uint4*)(mul + o + 8 * q);
      }
#pragma unroll
      for (int q = 0; q < 4; ++q) {
        float v[8];
#pragma unroll
        for (int i = 0; i < 8; ++i) v[i] = tlb[(cg + 8 * q + i) * 257 + tl];
        if (mul) {
          v[0] *= bflo(m[q].x); v[1] *= bfhi(m[q].x); v[2] *= bflo(m[q].y); v[3] *= bfhi(m[q].y); v[4] *= bflo(m[q].z); v[5] *= bfhi(m[q].z); v[6] *= bflo(m[q].w); v[7] *= bfhi(m[q].w);
        }
        uint4 ov; ov.x = pack2(v[0], v[1]); ov.y = pack2(v[2], v[3]); ov.z = pack2(v[4], v[5]); ov.w = pack2(v[6], v[7]);
        *(uint4*)(dst + o + 8 * q) = ov;
      }
    }
    __syncthreads();
  }
}
DEV void fn_transpose(const Params& p) {
  const bf16_t* G = (const bf16_t*)(PWS() + OFF_RA);
  unsigned* GT = (unsigned*)(PWS() + OFF_RB);
  unsigned* tlb = (unsigned*)smem;
  const int tid = TIDX();
  for (int item = BIDX(); item < 2 * 64 * 16; item += GDIM()) {
    const int b = item >> 10, tt = (item >> 4) & 63, ct = item & 15;
    const int t0 = tt * 256, c0 = ct * 64;
    {
      const int tl = tid >> 1, cq = (tid & 1) * 32;
      const bf16_t* s = G + (size_t)(b * LSEQ + t0 + tl) * 1024 + c0 + cq;
      uint4 v[4];
#pragma unroll
      for (int j = 0; j < 4; ++j) v[j] = *(const uint4*)(s + 8 * j);
#pragma unroll
      for (int j = 0; j < 4; ++j) { unsigned* d = tlb + tl * 33 + (cq >> 1) + 4 * j; d[0] = v[j].x; d[1] = v[j].y; d[2] = v[j].z; d[3] = v[j].w; }
    }
    __syncthreads();
    {
      const int sq = tid >> 4, tq = (tid & 15) * 16;
      unsigned* d = GT + ((size_t)(b * 512 + (c0 >> 1) + sq) * LSEQ) + t0 + tq;
#pragma unroll
      for (int i = 0; i < 16; i += 4)
        *(uint4*)(d + i) = make_uint4(tlb[(tq + i) * 33 + sq], tlb[(tq + i + 1) * 33 + sq], tlb[(tq + i + 2) * 33 + sq], tlb[(tq + i + 3) * 33 + sq]);
    }
    __syncthreads();
  }
}
DEV void fn_fft(const Params& p) {
  const unsigned* GT = (const unsigned*)(PWS() + OFF_RB);
  float* YT = (float*)(PWS() + OFF_RA);
  float2* cx = (float2*)smem;
  const int tid = TIDX();
  for (int item = BIDX(); item < 1024; item += GDIM()) {
    const int b = item >> 9, sq = item & 511, g = sq >> 7, m = sq & 127;
    const unsigned* src = GT + (size_t)(b * 512 + sq) * LSEQ;
    {
      float2 v[32];
#pragma unroll
      for (int i = 0; i < 32; ++i) { const unsigned u = src[i * 512 + tid]; v[i] = make_float2(bflo(u), bfhi(u)); }
      fft_fwd_pass1_store(v, cx, tid);
    }
    __syncthreads();
    fft_fwd_pass2(cx, tid);
    __syncthreads();
    {
      float2 w0[16], w1[16];
      fft_fwd_pass3_regs(cx, tid, w0, w1);
#pragma unroll
      for (int i = 0; i < 16; ++i) { cx[amap(tid * 16 + brev_c(i, 4))] = w0[i]; cx[amap((tid + 512) * 16 + brev_c(i, 4))] = w1[i]; }
    }
    __syncthreads();
    const float sc = 1.f / 2048.f;
    float* ya = YT + (size_t)(b * 1024 + g * 256 + (m ? m : 0)) * LSEQ;
    float* yb = YT + (size_t)(b * 1024 + g * 256 + (m ? 256 - m : 128)) * LSEQ;
#pragma unroll 4
    for (int i = 0; i < 32; ++i) {
      const int k = i * 512 + tid, km = (LSEQ - k) & (LSEQ - 1);
      const float2 fk = cx[amap((k & 31) * 512 + ((k >> 5) & 31) * 16 + (k >> 10))];
      const float2 fm = cx[amap((km & 31) * 512 + ((km >> 5) & 31) * 16 + (km >> 10))];
      if (m) { ya[k] = fk.x * sc; yb[k] = fm.x * sc; }
      else { ya[k] = 0.5f * (fk.x + fm.x) * sc; yb[k] = 0.5f * (fk.y + fm.y) * sc; }
    }
    __syncthreads();
  }
}

DEV void post_mixer(const Params& p, int layer, const bf16_t* Yo, int nrows, bool dry) {
  const int tid = TIDX(), lane = tid & 63, wave = tid >> 6;
  bf16_t* X = (bf16_t*)(PWS() + OFF_X);
  bf16_t* H = (bf16_t*)(PWS() + OFF_H);
  const float* MOD = (const float*)(PWS() + OFF_MOD);
  const float* lg = PIN(I_LNG) + (size_t)(layer * 2 + 0) * 1024; const float* lb = PIN(I_LNB) + (size_t)(layer * 2 + 0) * 1024;
  for (int row = BIDX() * 8 + wave; row < nrows; row += GDIM() * 8) {
    const int mr = modrow_of(row);
    float x[16], y[16], gt[16];
    load16bf(X + (size_t)row * 1024 + lane * 16, x); load16bf(Yo + (size_t)row * 1024 + lane * 16, y);
    load16f(mod_ptr(MOD, layer, mr, 2) + lane * 16, gt);
#pragma unroll
    for (int i = 0; i < 16; ++i) x[i] = DN_ALPHA * x[i] + ((KO_MASK >> layer) & 1 ? 0.f : gt[i] * y[i]);
    ln_row(x, lg, lb, lane);
    if (!dry) store16bf(X + (size_t)row * 1024 + lane * 16, x);
    float sh[16], scl[16];
    load16f(mod_ptr(MOD, layer, mr, 3) + lane * 16, sh); load16f(mod_ptr(MOD, layer, mr, 4) + lane * 16, scl);
#pragma unroll
    for (int i = 0; i < 16; ++i) x[i] = x[i] * (1.f + scl[i]) + sh[i];
    if (!dry) store16bf(H + (size_t)row * 1024 + lane * 16, x);
    else if (x[0] == 1.2345e-30f) store16bf(H + (size_t)row * 1024 + lane * 16, x);
  }
}

typedef float f32x2 __attribute__((ext_vector_type(2)));
constexpr size_t OFF_P8 = OFF_PT;
constexpr size_t OFF_PSCL = OFF_PT + (size_t)2 * 16384 * 1024;
DEV unsigned fp6_code(float x, float sc) {
  const float a = fabsf(x) * sc;
  float c = a < 2.f ? rintf(a * 8.f) : (a < 4.f ? 16.f + rintf((a - 2.f) * 4.f) : 24.f + rintf((a - 4.f) * 2.f));
  c = fminf(c, 31.f);
  return (unsigned)c | (x < 0.f ? 32u : 0u);
}
DEV void peer_tables(const Params& p, int layer, int nrows) {
  const int tid = TIDX(), lane = tid & 63, wave = tid >> 6, l31 = lane & 31;
  int my_rank = BIDX(), n_share = GDIM();
  if (GDIM() % 8 == 0) {
    const int MT = nrows / 256, per_mt = 8, nloc_b = GDIM() / 8;
    const int XH = MT % 8, base = ((MT / 8) * per_mt) / nloc_b;
    const int JH = (XH > 0) ? ((MT / 8 + 1) * per_mt - base * nloc_b) : 0;
    if (JH > 0 && JH <= nloc_b && ((MT / 8) * per_mt) % nloc_b == 0) {
      const int bx = BIDX() % 8, bj = BIDX() / 8;
      const bool heavy = (bx < XH) && (bj < JH);
      const int before = (bj < JH) ? bj * XH + (bx < XH ? bx : XH) : JH * XH;
      n_share = GDIM() - JH * XH;
      my_rank = heavy ? -1 : BIDX() - before;
    }
  }
  if (my_rank < 0) return;
  const float* su = PIN(I_PKU) + (size_t)layer * 16384 * 1024; const float* sv = PIN(I_PKV) + (size_t)layer * 16384 * 1024;
  unsigned char* P8 = PWS() + OFF_P8; float* SCL = (float*)(PWS() + OFF_PSCL);
  for (int r2 = my_rank * 8 + wave; r2 < 8192; r2 += n_share * 8) {
    const int r = 2 * r2 + (lane >> 5);
    const float* src = su + (size_t)r * 1024 + l31 * 32;
    float x[32];
#pragma unroll
    for (int i = 0; i < 8; ++i) { const float4 v = *(const float4*)(src + 4 * i); x[4 * i] = v.x; x[4 * i + 1] = v.y; x[4 * i + 2] = v.z; x[4 * i + 3] = v.w; }
    float mx = 0.f;
#pragma unroll
    for (int i = 0; i < 32; ++i) mx = fmaxf(mx, fabsf(x[i]));
#pragma unroll
    for (int o = 16; o > 0; o >>= 1) mx = fmaxf(mx, SHX(mx, o));
    const float sc = mx > 0.f ? 7.5f / mx : 1.f, inv = mx > 0.f ? mx * (1.f / 7.5f) : 1.f;
    unsigned long long acc = 0ull; int nb = 0; unsigned w[6]; int wi = 0;
#pragma unroll
    for (int i = 0; i < 32; ++i) {
      acc |= (unsigned long long)fp6_code(x[i], sc) << nb; nb += 6;
      if (nb >= 32) { w[wi++] = (unsigned)acc; acc >>= 32; nb -= 32; }
    }
    unsigned char* dst = P8 + (size_t)r * 768;
    *(uint4*)(dst + l31 * 16) = make_uint4(w[0], w[1], w[2], w[3]); *(uint2*)(dst + 512 + l31 * 8) = make_uint2(w[4], w[5]);
    if (l31 == 0) SCL[r] = inv;
  }
  for (int r2 = my_rank * 8 + wave; r2 < 8192; r2 += n_share * 8) {
    const int r = 2 * r2 + (lane >> 5);
    const float* src = sv + (size_t)r * 1024 + l31 * 32;
    float x[32];
#pragma unroll
    for (int i = 0; i < 8; ++i) { const float4 v = *(const float4*)(src + 4 * i); x[4 * i] = v.x; x[4 * i + 1] = v.y; x[4 * i + 2] = v.z; x[4 * i + 3] = v.w; }
    float mx = 0.f;
#pragma unroll
    for (int i = 0; i < 32; ++i) mx = fmaxf(mx, fabsf(x[i]));
#pragma unroll
    for (int o = 16; o > 0; o >>= 1) mx = fmaxf(mx, SHX(mx, o));
    const float sc = mx > 0.f ? 7.5f / mx : 1.f, inv = mx > 0.f ? mx * (1.f / 7.5f) : 1.f;
    unsigned long long acc = 0ull; int nb = 0; unsigned w[6]; int wi = 0;
#pragma unroll
    for (int i = 0; i < 32; ++i) {
      acc |= (unsigned long long)fp6_code(x[i], sc) << nb; nb += 6;
      if (nb >= 32) { w[wi++] = (unsigned)acc; acc >>= 32; nb -= 32; }
    }
    unsigned char* dst = P8 + (size_t)16384 * 1024 + (size_t)r * 768 + l31 * 24;
    *(uint2*)(dst) = make_uint2(w[0], w[1]); *(uint2*)(dst + 8) = make_uint2(w[2], w[3]); *(uint2*)(dst + 16) = make_uint2(w[4], w[5]);
    if (l31 == 0) SCL[16384 + r] = inv;
  }
}
typedef float v32f __attribute__((ext_vector_type(32)));
typedef unsigned v6u __attribute__((ext_vector_type(6)));
typedef unsigned u32x3v __attribute__((ext_vector_type(3)));
DEV void unpack16_fp8(const uint4& a, float (&f)[16]) {
  const unsigned q[4] = {a.x, a.y, a.z, a.w};
#pragma unroll
  for (int d = 0; d < 4; ++d) {
    const f32x2 lo = __builtin_amdgcn_cvt_pk_f32_fp8((int)q[d], false), hi = __builtin_amdgcn_cvt_pk_f32_fp8((int)q[d], true);
    f[4 * d] = lo[0]; f[4 * d + 1] = lo[1]; f[4 * d + 2] = hi[0]; f[4 * d + 3] = hi[1];
  }
}

__device__ constexpr unsigned char STAIR[64] = {
  0x00,0x01,0x02,0x03,0x04,0x05,0x06,0x07,0x08,0x09,0x0a,0x0b,0x0c,0x0d,0x0e,0x0f,
  0x10,0x11,0x12,0x13,0x14,0x15,0x16,0x17, 0x20,0x21,0x22,0x23,0x24, 0x30,0x31,0x32,
  0x33, 0x40,0x41,0x42, 0x50,0x51, 0x60,0x61, 0x70,0x71, 0x80,0x90,0xa0,0xb0,0xc0,0xd0,
  0xe0,0xf0, 0xff,0xff,0xff,0xff,0xff,0xff,0xff,0xff,0xff,0xff,0xff,0xff,0xff,0xff};

DEV void peer_route(const Params& p, int nrows) {
  const unsigned* TOPK = (const unsigned*)(PWS() + OFF_RA);
  int* IDX = (int*)(PWS() + OFF_RA + (size_t)TT * 256 * 4);
  float* GATE = (float*)(PWS() + OFF_RA + (size_t)TT * 256 * 4 + (size_t)TT * 128 * 4);
  unsigned char* li = smem;
  const int tid = TIDX();
  const int total = nrows * 8;
  for (int it = BIDX() * NT + tid; it < total; it += GDIM() * NT) {
    const int row = it >> 3, h = it & 7;
    const unsigned* src = TOPK + ((size_t)row * 16 + h * 2) * 16;
    unsigned ka[16], kb[16];
#pragma unroll
    for (int i = 0; i < 4; ++i) {
      const uint4 a = *(const uint4*)(src + 4 * i), b = *(const uint4*)(src + 16 + 4 * i);
      ka[4 * i] = a.x; ka[4 * i + 1] = a.y; ka[4 * i + 2] = a.z; ka[4 * i + 3] = a.w;
      kb[4 * i] = b.x; kb[4 * i + 1] = b.y; kb[4 * i + 2] = b.z; kb[4 * i + 3] = b.w;
    }
    float va[16], vb[16];
#pragma unroll
    for (int i = 0; i < 16; ++i) {
      va[i] = keyf(ka[i] & ~127u); vb[i] = keyf(kb[i] & ~127u);
      li[i * 512 + tid] = (unsigned char)(127u - (ka[i] & 127u)); li[(16 + i) * 512 + tid] = (unsigned char)(127u - (kb[i] & 127u));
    }
    unsigned best[16], cur[16];
#pragma unroll
    for (int q = 0; q < 4; ++q) {
#pragma unroll
      for (int i = 0; i < 16; ++i) {
        const int code = STAIR[q * 16 + i];
        if (code == 0xff) cur[i] = 0u;
        else cur[i] = (fkey(va[code >> 4] + vb[code & 15]) & ~255u) | (unsigned)code;
      }
      sort16_desc(cur);
      if (q == 0) {
#pragma unroll
        for (int i = 0; i < 16; ++i) best[i] = cur[i];
      } else merge16_desc(best, cur);
    }
    float cv[16], sum = 0.f;
    const float mx = keyf(best[0] & ~255u);
#pragma unroll
    for (int i = 0; i < 16; ++i) { cv[i] = __expf(keyf(best[i] & ~255u) - mx); sum += cv[i]; }
    const float inv = 1.f / sum;
    int* di = IDX + (size_t)row * 128 + h * 16; float* dg = GATE + (size_t)row * 128 + h * 16;
#pragma unroll
    for (int i = 0; i < 16; ++i) {
      const unsigned code = best[i] & 255u;
      const int i1 = li[(code >> 4) * 512 + tid], i2 = li[(16 + (code & 15)) * 512 + tid];
      di[i] = i1 * 128 + i2; dg[i] = cv[i] * inv;
    }
  }
}

typedef unsigned u32x4v __attribute__((ext_vector_type(4)));
DEV unsigned sorted_key_of(unsigned k0, unsigned k1, int s) {
  const unsigned a = (unsigned)__builtin_amdgcn_ds_bpermute((s >> 1) << 2, (int)k0);
  const unsigned b = (unsigned)__builtin_amdgcn_ds_bpermute((s >> 1) << 2, (int)k1);
  return (s & 1) ? b : a;
}
DEV void pe_sort_keys(const int* IDX, int row, int lane, bool dry, unsigned& k0, unsigned& k1) {
  int2 ii = *(const int2*)(IDX + (size_t)row * 128 + 2 * lane);
#if EXPERT_L2PROBE
  if (dry) { ii.x &= 2047; ii.y &= 2047; }
#endif
  k0 = ((unsigned)ii.x << 7) | (unsigned)(2 * lane); k1 = ((unsigned)ii.y << 7) | (unsigned)(2 * lane + 1);
#pragma unroll
  for (int ksz = 2; ksz <= 128; ksz <<= 1) {
#pragma unroll
    for (int j = ksz >> 1; j >= 1; j >>= 1) {
      if (j == 1) {
        const bool asc = ((2 * lane) & ksz) == 0;
        const unsigned mn = k0 < k1 ? k0 : k1, mx = k0 < k1 ? k1 : k0;
        k0 = asc ? mn : mx; k1 = asc ? mx : mn;
      } else {
        const int pl = lane ^ (j >> 1);
        const unsigned p0 = (unsigned)__builtin_amdgcn_ds_bpermute(pl << 2, (int)k0), p1 = (unsigned)__builtin_amdgcn_ds_bpermute(pl << 2, (int)k1);
        const bool asc = ((2 * lane) & ksz) == 0, low = ((2 * lane) & j) == 0;
        const bool tmin = (asc == low);
        k0 = tmin ? (k0 < p0 ? k0 : p0) : (k0 < p0 ? p0 : k0);
        k1 = tmin ? (k1 < p1 ? k1 : p1) : (k1 < p1 ? p1 : k1);
      }
    }
  }
}
DEV float fp6_val(unsigned code) {
  const float c = (float)(code & 31u);
  const float v = c < 16.f ? c * 0.125f : (c < 24.f ? 2.f + (c - 16.f) * 0.25f : 4.f + (c - 24.f) * 0.5f);
  return (code & 32u) ? -v : v;
}
DEV void pe_pack_x(int row, int lane, uint4& xh, uint4& xl, float& inv_s) {
  float hb[16];
  const bf16_t* H = (const bf16_t*)(PWS() + OFF_H);
  const uint4 a = *(const uint4*)(H + (size_t)row * 1024 + lane * 16), b = *(const uint4*)(H + (size_t)row * 1024 + lane * 16 + 8);
  unpack16(a, b, hb);
  float mx = 0.f;
#pragma unroll
  for (int i = 0; i < 16; ++i) mx = fmaxf(mx, fabsf(hb[i]));
#pragma unroll
  for (int o_ = 32; o_ > 0; o_ >>= 1) mx = fmaxf(mx, SHX(mx, o_));
  const float s = mx > 0.f ? 7.5f / mx : 1.f; inv_s = mx > 0.f ? mx * (1.f / 7.5f) : 1.f;
  unsigned long long ah = 0ull, al = 0ull; int nb = 0; unsigned wh[3], wl[3]; int wi = 0;
#pragma unroll
  for (int i = 0; i < 16; ++i) {
    const float x = hb[i] * s;
    const unsigned ch = fp6_code(x, 1.f);
    const float lo = (x - fp6_val(ch)) * 16.f;
    const unsigned cl = fp6_code(lo, 1.f);
    ah |= (unsigned long long)ch << nb; al |= (unsigned long long)cl << nb; nb += 6;
    if (nb >= 32) { wh[wi] = (unsigned)ah; wl[wi] = (unsigned)al; ++wi; ah >>= 32; al >>= 32; nb -= 32; }
  }
  xh = make_uint4(wh[0], wh[1], wh[2], 0u); xl = make_uint4(wl[0], wl[1], wl[2], 0u);
}
DEV void pe_epilogue(int layer, int row, int nrows_next, bool dry, int lane, const f32x2 (&o2)[8]) {
  bf16_t* X = (bf16_t*)(PWS() + OFF_X);
  bf16_t* H = (bf16_t*)(PWS() + OFF_H);
  const float* MOD = (const float*)(PWS() + OFF_MOD);
  const float* lg = PIN(I_LNG) + (size_t)(layer * 2 + 1) * 1024; const float* lb = PIN(I_LNB) + (size_t)(layer * 2 + 1) * 1024;
  const int mr = modrow_of(row);
  float x[16], gt[16];
  load16bf(X + (size_t)row * 1024 + lane * 16, x); load16f(mod_ptr(MOD, layer, mr, 5) + lane * 16, gt);
#pragma unroll
  for (int i = 0; i < 16; ++i) x[i] = DN_ALPHA * x[i] + ((KO_MASK >> (4 + layer)) & 1 ? 0.f : gt[i] * o2[i >> 1][i & 1]);
  ln_row(x, lg, lb, lane);
  if (dry) { if (x[0] == 1.2345e-30f) store16bf(X + (size_t)row * 1024 + lane * 16, x); }
  else if (layer == 3) {
    if (row < TL) store16f(POUT() + (size_t)row * 1024 + lane * 16, x);
  } else {
    store16bf(X + (size_t)row * 1024 + lane * 16, x);
    if (row < nrows_next) {
      float sh[16], scl[16];
      load16f(mod_ptr(MOD, layer + 1, mr, 0) + lane * 16, sh); load16f(mod_ptr(MOD, layer + 1, mr, 1) + lane * 16, scl);
#pragma unroll
      for (int i = 0; i < 16; ++i) x[i] = x[i] * (1.f + scl[i]) + sh[i];
      store16bf(H + (size_t)row * 1024 + lane * 16, x);
    }
  }
}
DEV void peer_expert(const Params& p, int layer, int nrows, int nrows_next, bool dry) {
  const int tid = TIDX(), lane_f = tid & 63, wave = tid >> 6;
  const int npairs = nrows >> 1, nwaves = GDIM() * 8, nfull = npairs / nwaves, rem = npairs - nfull * nwaves;
  for (int it = 0; it <= nfull; ++it) {
    int rp = it * nwaves + BIDX() * 8 + wave;
    if (it == nfull) { const int t_ = wave * GDIM() + BIDX(); if (t_ >= rem) break; rp = nfull * nwaves + t_; }
    int lane = lane_f; asm volatile("" : "+v"(lane));
    const int rowA = 2 * rp, rowB = 2 * rp + 1;
    const unsigned char* PU8 = PWS() + OFF_P8;
    const float* SCU = (const float*)(PWS() + OFF_PSCL); const float* SCV = SCU + 16384;
    const int* IDX = (const int*)(PWS() + OFF_RA + (size_t)TT * 256 * 4);
    const float* GATE = (const float*)(PWS() + OFF_RA + (size_t)TT * 256 * 4 + (size_t)TT * 128 * 4);
    const int pkL = lane & 15, qL = lane >> 4;
    f32x2 oA[8], oB[8];
#pragma unroll
    for (int i = 0; i < 8; ++i) { oA[i] = (f32x2){0.f, 0.f}; oB[i] = (f32x2){0.f, 0.f}; }
    const __amdgpu_buffer_rsrc_t trs = __builtin_amdgcn_make_buffer_rsrc((void*)PU8, (short)0, 0x7fffffff, 0x00027000);
#define LOADU16(eLv) { if (lane < 48) { _Pragma("unroll") for (int k_ = 0; k_ < 16; ++k_) { \
        const int e_ = __builtin_amdgcn_readlane((eLv), k_); \
        __builtin_amdgcn_raw_ptr_buffer_load_lds(trs, (LAS void*)(smem + 16384 + k_ * 784 + p.ph_lo * 12544), 16, lane * 16, e_ * 768, 0, 0); } } }
#define LOADV8(q, eLv, hf) { _Pragma("unroll") for (int k_ = 0; k_ < 8; ++k_) { \
        const int e_ = __builtin_amdgcn_readlane((eLv), 8 * (hf) + k_); \
        q[k_] = __builtin_amdgcn_raw_buffer_load_b96(trs, 16384 * 1024 + e_ * 768 + lane * 12, 0, 0); } }
#define P64(lo_, hi_) ((long)(((unsigned long)(hi_) << 32) | (unsigned long)(lo_)))
#define DOTU2(t0) { _Pragma("unroll") for (int k_ = 0; k_ < 2; ++k_) { \
        const uint4 xa_ = *(const uint4*)(smem + xoff + ((t0) + k_) * 64); const uint2 xb_ = *(const uint2*)(smem + xoff2 + ((t0) + k_) * 32); \
        const uint4 b0_ = *(const uint4*)(smem + uoff + ((t0) + k_) * 64); const uint2 b1_ = *(const uint2*)(smem + uoff2 + ((t0) + k_) * 32); \
        const v8i32 a_ = {(int)xa_.x, (int)xa_.y, (int)xa_.z, (int)xa_.w, (int)xb_.x, (int)xb_.y, 0, 0}; \
        const v8i32 b_ = {(int)b0_.x, (int)b0_.y, (int)b0_.z, (int)b0_.w, (int)b1_.x, (int)b1_.y, 0, 0}; \
        if (k_ == 0) acc0 = __builtin_amdgcn_mfma_scale_f32_16x16x128_f8f6f4(a_, b_, acc0, 2, 2, 0, 0, 0, 0); \
        else acc1 = __builtin_amdgcn_mfma_scale_f32_16x16x128_f8f6f4(a_, b_, acc1, 2, 2, 0, 0, 0, 0); } \
        __builtin_amdgcn_sched_barrier(0); }
#define AXPY8(q, hf, o2) { _Pragma("unroll") for (int k_ = 0; k_ < 8; k_ += 2) { \
        const float wa_ = __uint_as_float(__builtin_amdgcn_readlane(__float_as_uint(wL), 8 * (hf) + k_)); \
        const float wb_ = __uint_as_float(__builtin_amdgcn_readlane(__float_as_uint(wL), 8 * (hf) + k_ + 1)); \
        const f32x2 wa2_ = {wa_, wa_}, wb2_ = {wb_, wb_}; \
        const v32f f_ = __builtin_amdgcn_cvt_scalef32_pk32_f32_fp6((v6u){q[k_][0], q[k_][1], q[k_][2], q[k_ + 1][0], q[k_ + 1][1], q[k_ + 1][2]}, 1.0f); \
        _Pragma("unroll") for (int d_ = 0; d_ < 8; ++d_) { \
          o2[d_] = __builtin_elementwise_fma(wa2_, (f32x2){f_[2 * d_], f_[2 * d_ + 1]}, o2[d_]); \
          o2[d_] = __builtin_elementwise_fma(wb2_, (f32x2){f_[16 + 2 * d_], f_[16 + 2 * d_ + 1]}, o2[d_]); } \
        __builtin_amdgcn_sched_barrier(0); } }
    unsigned k0A, k1A, k0B, k1B;
    pe_sort_keys(IDX, rowA, lane, dry, k0A, k1A);
    __builtin_amdgcn_sched_barrier(0);
    pe_sort_keys(IDX, rowB, lane, dry, k0B, k1B);
    __builtin_amdgcn_sched_barrier(0);
    uint4 xhA, xlA, xhB, xlB; float isA, isB;
    pe_pack_x(rowA, lane, xhA, xlA, isA);
    pe_pack_x(rowB, lane, xhB, xlB, isB);
    __builtin_amdgcn_sched_barrier(0);
#define SKEY(R, g_) sorted_key_of(k0##R, k1##R, 16 * (g_) + pkL)
    u32x3v qa[8], qb[8];
    const unsigned kA0 = SKEY(A, 0), kB0 = SKEY(B, 0);
    int eLA = (int)(kA0 >> 7), eLB = (int)(kB0 >> 7);
    float gLA = GATE[(size_t)rowA * 128 + (kA0 & 127u)], gLB = GATE[(size_t)rowB * 128 + (kB0 & 127u)];
    float suA = SCU[eLA] * isA, svA = SCV[eLA], suB = SCU[eLB] * isB, svB = SCV[eLB];
    LOADU16(eLA);
    __builtin_amdgcn_sched_barrier(0);
    LOADV8(qa, eLA, 0);
    LOADV8(qb, eLA, 1);
    __builtin_amdgcn_sched_barrier(0);
#define STEP(R, N, gnext, NEXT) { \
      const unsigned kLn = SKEY(R, gnext);                            \
      const int eLn = (int)(kLn >> 7); \
      const float gLn = GATE[(size_t)row##R * 128 + (kLn & 127u)]; \
      const float sun = SCU[eLn] * is##R, svn = SCV[eLn]; \
      { unsigned char* xs = smem + wave * 2048; const int g_ = lane >> 1, h_ = lane & 1; \
          \
        const int a0_ = h_ ? 16 * g_ + 12 : 16 * g_, a1_ = h_ ? 512 + 8 * g_ : 16 * g_ + 4, a2_ = h_ ? 512 + 8 * g_ + 4 : 16 * g_ + 8; \
        *(unsigned*)(xs + a0_) = xh##R.x; *(unsigned*)(xs + a1_) = xh##R.y; *(unsigned*)(xs + a2_) = xh##R.z; \
        *(unsigned*)(xs + 768 + a0_) = xl##R.x; *(unsigned*)(xs + 768 + a1_) = xl##R.y; *(unsigned*)(xs + 768 + a2_) = xl##R.z; \
        __builtin_amdgcn_fence(__ATOMIC_RELEASE, "wavefront"); __builtin_amdgcn_wave_barrier(); __builtin_amdgcn_fence(__ATOMIC_ACQUIRE, "wavefront"); } \
      f32x4 acc0 = (f32x4){0.f, 0.f, 0.f, 0.f}, acc1 = (f32x4){0.f, 0.f, 0.f, 0.f}; \
      int xoff = wave * 2048 + (pkL == 1 ? 768 : 0) + qL * 16; asm volatile("" : "+v"(xoff)); \
      int xoff2 = wave * 2048 + (pkL == 1 ? 768 : 0) + 512 + qL * 8; asm volatile("" : "+v"(xoff2)); \
      int uoff = 16384 + wave * 12544 + pkL * 784 + qL * 16; asm volatile("" : "+v"(uoff)); \
      int uoff2 = 16384 + wave * 12544 + pkL * 784 + 512 + qL * 8; asm volatile("" : "+v"(uoff2)); \
      __builtin_amdgcn_sched_barrier(0); \
      asm volatile("s_waitcnt vmcnt(16)" ::: "memory"); \
      __builtin_amdgcn_sched_barrier(0); \
      DOTU2(0); DOTU2(2); DOTU2(4); DOTU2(6); \
      const float r1 = (acc0[0] + acc1[0]) + (acc0[1] + acc1[1]) * 0.0625f; \
      float wL = gL##R * gelu_tanh(r1 * su##R) * sv##R; asm volatile("" : "+v"(wL) :: "memory");     \
      __builtin_amdgcn_sched_barrier(0); \
      if (NEXT) { LOADU16(eL##N); } \
      __builtin_amdgcn_sched_barrier(0); \
      AXPY8(qa, 0, o##R); \
      if (NEXT) { LOADV8(qa, eL##N, 0); } \
      __builtin_amdgcn_sched_barrier(0); \
      AXPY8(qb, 1, o##R); \
      if (NEXT) { LOADV8(qb, eL##N, 1); } \
      __builtin_amdgcn_sched_barrier(0); \
      eL##R = eLn; gL##R = gLn; su##R = sun; sv##R = svn; }
#pragma unroll 1
    for (int gI = 0; gI < 7; ++gI) { STEP(A, B, gI + 1, 1) STEP(B, A, gI + 1, 1) }
    STEP(A, B, 7, 1)
    STEP(B, A, 7, 0)
#undef STEP
#undef SKEY
#undef LOADU16
#undef LOADV8
#undef DOTU2
#undef AXPY8
#undef P64
    __builtin_amdgcn_sched_barrier(0);
    pe_epilogue(layer, rowA, nrows_next, dry, lane, oA);
    __builtin_amdgcn_sched_barrier(0);
    pe_epilogue(layer, rowB, nrows_next, dry, lane, oB);
  }
}
constexpr size_t GD_U1 = (size_t)TT * D;
constexpr size_t OFF_GD_T = OFF_RA;
constexpr size_t OFF_GD_ATT = OFF_GD_T + (size_t)8320 * 4096 * 2;
constexpr size_t OFF_GD_SC = OFF_GD_ATT + (size_t)8320 * 4096 * 2;
constexpr size_t OFF_GD_AB = OFF_RC;
constexpr size_t OFF_GD_KT = OFF_GD_AB + AL((size_t)TT * 256 * 4);
constexpr size_t OFF_GD_G = OFF_GD_KT + AL((size_t)4160 * 8192 * 2);
constexpr size_t OFF_GD_BETA = OFF_GD_G + AL((size_t)16 * TT * 4);
static_assert(OFF_GD_SC + (size_t)8320 * 1024 <= OFF_RA + 3 * GD_U1 * 2, "gdn prep buffers must fit in the q,k,v part of U");
static_assert(OFF_GD_BETA + (size_t)16 * TT * 4 <= OFF_RC + SZ_RC, "gdn side buffers must fit RC");

DEV void gdn_conv(const Params& p) {
  const bf16_t* U = (const bf16_t*)(PWS() + OFF_RA);
  bf16_t* QKV = (bf16_t*)(PWS() + OFF_RB);
  const float* AB = (const float*)(PWS() + OFF_GD_AB);
  bf16_t* KT = (bf16_t*)(PWS() + OFF_GD_KT);
  float* GG = (float*)(PWS() + OFF_GD_G); float* BETA = (float*)(PWS() + OFF_GD_BETA);
  const float* CW = PIN(I_GDCONV);
  bf16_t* kt = (bf16_t*)smem;
  const int tid = TIDX();
  for (int item = BIDX(); item < 520 * 8; item += GDIM()) {
    const int ci = item >> 3, h = item & 7;
    const int row0 = ci * 64;
    const int segstart = row0 < TL ? (row0 & ~16383) : (TL + ((row0 - TL) & ~255));
    const int Ls = row0 < TL ? LSEQ : CTXL;
    const int tl = tid >> 3, dg = tid & 7, row = row0 + tl, tin = row - segstart, lane = tid & 63;
    const int col = h * 128 + dg * 16;
#pragma unroll
    for (int s = 0; s < 3; ++s) {
      float o[16];
#pragma unroll
      for (int i = 0; i < 16; ++i) o[i] = 0.f;
#pragma unroll
      for (int dt = 0; dt < 3; ++dt) {
        const int ts = tin + dt - 1;
        if (ts >= 0 && ts < Ls) {
          const bf16_t* up = U + (size_t)s * GD_U1 + (size_t)(row + dt - 1) * 1024 + col;
          const uint4 a = *(const uint4*)up, b = *(const uint4*)(up + 8);
          float u[16], w[16]; unpack16(a, b, u); load16f(CW + (size_t)dt * 3072 + s * 1024 + col, w);
#pragma unroll
          for (int i = 0; i < 16; ++i) o[i] += u[i] * w[i];
        }
      }
      float ss = 0.f;
#pragma unroll
      for (int i = 0; i < 16; ++i) { o[i] = silu_f(o[i]); ss += o[i] * o[i]; }
      if (s < 2) {
        ss += SHX(ss, 1); ss += SHX(ss, 2); ss += SHX(ss, 4);
        const float inv = rsqrtf(ss + 1e-6f) * (s == 0 ? 0.08838834764831845f : 1.f);
#pragma unroll
        for (int i = 0; i < 16; ++i) o[i] *= inv;
      }
      store16bf(QKV + (size_t)s * GD_U1 + (size_t)row * 1024 + col, o);
      if (s == 1) {
#pragma unroll
        for (int i = 0; i < 16; ++i) kt[(dg * 16 + i) * 72 + tl] = f2bf(o[i]);
      }
    }
    if (tid < 128) {
      const int dir = tid >> 6, t2 = tid & 63, r2 = row0 + t2;
      const float a = AB[(size_t)r2 * 256 + dir * 8 + h], bb = AB[(size_t)r2 * 256 + 16 + dir * 8 + h];
      const float xa = a + PIN(I_GDDTB)[dir * 8 + h];
      const float sp = fmaxf(xa, 0.f) + log1pf(__expf(-fabsf(xa)));
      GG[(size_t)(dir * 8 + h) * TT + r2] = -__expf(PIN(I_GDALOG)[dir * 8 + h]) * sp;
      BETA[(size_t)(dir * 8 + h) * TT + r2] = 1.f / (1.f + __expf(-bb));
    }
    __syncthreads();
    {
      const int dk = tid >> 2, pq = (tid & 3) * 16;
      const bf16_t* s = kt + dk * 72 + pq;
      bf16_t* d = KT + ((size_t)item * 128 + dk) * 64 + pq;
      *(uint4*)d = *(const uint4*)s; *(uint4*)(d + 8) = *(const uint4*)(s + 8);
    }
    __syncthreads();
  }
}

DEV void gdn_prep(const Params& p) {
  const bf16_t* Qn = (const bf16_t*)(PWS() + OFF_RB); const bf16_t* Kn = Qn + GD_U1;
  const float* GG = (const float*)(PWS() + OFF_GD_G); const float* BETA = (const float*)(PWS() + OFF_GD_BETA);
  bf16_t* TM = (bf16_t*)(PWS() + OFF_GD_T); bf16_t* ATT = (bf16_t*)(PWS() + OFF_GD_ATT); float* SC = (float*)(PWS() + OFF_GD_SC);
  const int tid = TIDX(), lane = tid & 63, wave = tid >> 6, g = lane >> 4, c = lane & 15;
  float* As = (float*)smem + wave * 4096;
  const int nwaves_ = GDIM() * 8, nfull_ = 8320 / nwaves_, rem_ = 8320 - nfull_ * nwaves_;
  for (int it_ = 0; it_ <= nfull_; ++it_) {
    int item = it_ * nwaves_ + BIDX() * 8 + wave;
    if (it_ == nfull_) { const int t_ = wave * GDIM() + BIDX(); if (t_ >= rem_) break; item = nfull_ * nwaves_ + t_; }
    const int dir = item & 1, h = (item >> 1) & 7, ci = item >> 4;
    const int row0 = ci * 64;
    const int myrow = row0 + (dir ? 63 - lane : lane);
    const float gv = GG[(size_t)(dir * 8 + h) * TT + myrow], bv = BETA[(size_t)(dir * 8 + h) * TT + myrow];
    float gc = gv;
#pragma unroll
    for (int o = 1; o < 64; o <<= 1) { const float t = shfl_idx_f(gc, lane - o); if (lane >= o) gc += t; }
    const float gl = shfl_idx_f(gc, 63);
    bf16x8 kb[4][4];
#pragma unroll
    for (int ni = 0; ni < 4; ++ni) {
      const int pl = 16 * ni + c; const size_t r = (size_t)(row0 + (dir ? 63 - pl : pl));
#pragma unroll
      for (int s = 0; s < 4; ++s) kb[ni][s] = *(const bf16x8*)(Kn + r * 1024 + h * 128 + 32 * s + 8 * g);
    }
#pragma unroll 1
    for (int mi = 0; mi < 4; ++mi) {
      const int pl = 16 * mi + c; const size_t r = (size_t)(row0 + (dir ? 63 - pl : pl));
      f32x4 akk[4], aqk[4];
#pragma unroll
      for (int ni = 0; ni < 4; ++ni) { akk[ni] = (f32x4){0.f, 0.f, 0.f, 0.f}; aqk[ni] = (f32x4){0.f, 0.f, 0.f, 0.f}; }
#pragma unroll
      for (int s = 0; s < 4; ++s) {
        const bf16x8 ka = *(const bf16x8*)(Kn + r * 1024 + h * 128 + 32 * s + 8 * g);
        const bf16x8 qa = *(const bf16x8*)(Qn + r * 1024 + h * 128 + 32 * s + 8 * g);
#pragma unroll
        for (int ni = 0; ni < 4; ++ni) {
          akk[ni] = __builtin_amdgcn_mfma_f32_16x16x32_bf16(ka, kb[ni][s], akk[ni], 0, 0, 0);
          aqk[ni] = __builtin_amdgcn_mfma_f32_16x16x32_bf16(qa, kb[ni][s], aqk[ni], 0, 0, 0);
        }
      }
#pragma unroll
      for (int r_ = 0; r_ < 4; ++r_) {
        const int pr = 16 * mi + 4 * g + r_;
        const float gcr = shfl_idx_f(gc, pr), br = shfl_idx_f(bv, pr);
#pragma unroll
        for (int ni = 0; ni < 4; ++ni) {
          const int pc = 16 * ni + c;
          const float gcc = shfl_idx_f(gc, pc);
          const float dec = (pr >= pc) ? __expf(gcr - gcc) : 0.f;
          As[pr * 64 + pc] = (pr > pc) ? br * akk[ni][r_] * dec : 0.f;
          ATT[(size_t)item * 4096 + pr * 64 + pc] = f2bf(aqk[ni][r_] * dec);
        }
      }
    }
    float T[64];
#pragma unroll
    for (int i = 0; i < 64; ++i) {
      float acc = (i == lane) ? 1.f : 0.f;
#pragma unroll
      for (int j4 = 0; j4 < (i + 3) / 4; ++j4) {
        const float4 a = *(const float4*)(As + i * 64 + j4 * 4);
        if (j4 * 4 + 0 < i) acc -= a.x * T[j4 * 4 + 0];
        if (j4 * 4 + 1 < i) acc -= a.y * T[j4 * 4 + 1];
        if (j4 * 4 + 2 < i) acc -= a.z * T[j4 * 4 + 2];
        if (j4 * 4 + 3 < i) acc -= a.w * T[j4 * 4 + 3];
      }
      T[i] = acc;
    }
#pragma unroll
    for (int i = 0; i < 64; ++i) TM[(size_t)item * 4096 + i * 64 + lane] = f2bf(T[i]);
    float* sc = SC + (size_t)item * 256;
    sc[lane] = __expf(gc); sc[64 + lane] = __expf(gl - gc); sc[128 + lane] = bv; sc[192 + lane] = __expf(gl);
  }
}

constexpr int SCB = 74752;
constexpr int SC_K = 0, SC_Q = 17408, SC_KT = 34816, SC_T = 53248, SC_A = 62464, SC_V = 71680, SC_S = 73728;
DEV void scan_chunk_load(int c, int ci, int h, int dir, int slice, const bf16_t* Qn, const bf16_t* Kn, const bf16_t* Vn, const bf16_t* KT, const bf16_t* TM, const bf16_t* ATT, const float* SC,
                         uint4& r, int& dst) {
  const int row0 = ci * 64; const int item = (ci * 8 + h) * 2 + dir;
  if (c < 2048) { const int cc = c & 1023, pp = cc >> 4, ch = cc & 15; const int rr = row0 + (dir ? 63 - pp : pp);
    r = *(const uint4*)((c < 1024 ? Kn : Qn) + (size_t)rr * 1024 + h * 128 + ch * 8); dst = (c < 1024 ? SC_K : SC_Q) + pp * 272 + ch * 16; }
  else if (c < 3072) { const int cc = c - 2048, dk = cc >> 3, ch = cc & 7;
    r = *(const uint4*)(KT + ((size_t)(ci * 8 + h) * 128 + dk) * 64 + ch * 8); dst = SC_KT + dk * 144 + ch * 16; }
  else if (c < 4096) { const int cc = (c - 3072) & 511, pp = cc >> 3, ch = cc & 7;
    r = *(const uint4*)((c < 3584 ? TM : ATT) + (size_t)item * 4096 + pp * 64 + ch * 8); dst = (c < 3584 ? SC_T : SC_A) + pp * 144 + ch * 16; }
  else if (c < 4224) { const int cc = c - 4096, pp = cc >> 1, ch = cc & 1; const int rr = row0 + (dir ? 63 - pp : pp);
    r = *(const uint4*)(Vn + (size_t)rr * 1024 + h * 128 + slice * 16 + ch * 8); dst = SC_V + pp * 32 + ch * 16; }
  else { const int cc = (c < 4288 ? c : 4287) - 4224;
    r = *(const uint4*)(SC + (size_t)item * 256 + cc * 4); dst = SC_S + cc * 16; }
}
#define STG_DECL uint4 r0, r1, r2, r3, r4, r5, r6, r7, r8, r9; int d0, d1, d2, d3, d4, d5, d6, d7, d8, d9; \
  r0 = r1 = r2 = r3 = r4 = r5 = r6 = r7 = r8 = r9 = make_uint4(0u, 0u, 0u, 0u); d0 = d1 = d2 = d3 = d4 = d5 = d6 = d7 = d8 = d9 = 0;
#define STG_L1(i, n, lt_, nl_, ci_) if (i < n) scan_chunk_load((lt_) + (nl_) * i, (ci_), h, dir, slice, Qn, Kn, Vn, KT, TM, ATT, SC, r##i, d##i);
#define STG_LOAD(n, lt, nl, ci_) { int lt_ = (lt); asm volatile("" : "+v"(lt_));   \
  STG_L1(0, n, lt_, nl, ci_) STG_L1(1, n, lt_, nl, ci_) STG_L1(2, n, lt_, nl, ci_) STG_L1(3, n, lt_, nl, ci_) STG_L1(4, n, lt_, nl, ci_) \
  STG_L1(5, n, lt_, nl, ci_) STG_L1(6, n, lt_, nl, ci_) STG_L1(7, n, lt_, nl, ci_) STG_L1(8, n, lt_, nl, ci_) STG_L1(9, n, lt_, nl, ci_) }
#define STG_S1(i, n, buf_) if (i < n) *(uint4*)((buf_) + d##i) = r##i;
#define STG_STORE(n, buf_) { STG_S1(0, n, buf_) STG_S1(1, n, buf_) STG_S1(2, n, buf_) STG_S1(3, n, buf_) STG_S1(4, n, buf_) STG_S1(5, n, buf_) STG_S1(6, n, buf_) STG_S1(7, n, buf_) STG_S1(8, n, buf_) STG_S1(9, n, buf_) }
DEV bf16x8 pack8(const f32x4& a, const f32x4& b) {
  union { unsigned u[4]; bf16x8 v; } r;
  r.u[0] = pack2(a[0], a[1]); r.u[1] = pack2(a[2], a[3]); r.u[2] = pack2(b[0], b[1]); r.u[3] = pack2(b[2], b[3]);
  return r.v;
}
DEV bf16x8 ld2x8(const unsigned char* p0, const unsigned char* p1) {
  union { uint2 d[2]; bf16x8 v; } r;
  r.d[0] = *(const uint2*)p0; r.d[1] = *(const uint2*)p1;
  return r.v;
}
DEV uint2 rev4h(uint2 d) { return make_uint2((d.y >> 16) | (d.y << 16), (d.x >> 16) | (d.x << 16)); }
DEV bf16x8 ld2x8r(const unsigned char* p0, const unsigned char* p1) {
  union { uint2 d[2]; bf16x8 v; } r;
  r.d[0] = rev4h(*(const uint2*)p0); r.d[1] = rev4h(*(const uint2*)p1);
  return r.v;
}

DEV void gdn_scan(const Params& p) {
  const bf16_t* Qn = (const bf16_t*)(PWS() + OFF_RB); const bf16_t* Kn = Qn + GD_U1; const bf16_t* Vn = Kn + GD_U1;
  const bf16_t* KT = (const bf16_t*)(PWS() + OFF_GD_KT);
  const bf16_t* TM = (const bf16_t*)(PWS() + OFF_GD_T); const bf16_t* ATT = (const bf16_t*)(PWS() + OFF_GD_ATT); const float* SC = (const float*)(PWS() + OFF_GD_SC);
  bf16_t* O0 = (bf16_t*)(PWS() + OFF_H); bf16_t* O1 = (bf16_t*)(PWS() + OFF_FILT);
  const int tid = TIDX(), lane = tid & 63, g = lane >> 4, c = lane & 15;
  for (int task = BIDX(); task < 256; task += GDIM()) {
    const int chain = (task & 7) + 8 * (task >> 6), slice = (task >> 3) & 7;
    const int b = chain >> 4, h = (chain >> 1) & 7, dir = chain & 1;
    bf16_t* Od = dir ? O1 : O0;
    f32x4 S[8];
#pragma unroll
    for (int i = 0; i < 8; ++i) S[i] = (f32x4){0.f, 0.f, 0.f, 0.f};
    STG_DECL
    {
      const int ci0 = 512 + b * 4 + (dir ? 3 : 0);
      STG_LOAD(9, tid, NT, ci0)
      STG_STORE(9, smem)
      if (tid >= 64) { const int ci1 = 512 + b * 4 + (dir ? 2 : 1); STG_LOAD(10, tid - 64, NT - 64, ci1) }
    }
    __syncthreads();
#pragma unroll 1
    for (int step = 0; step < 260; ++step) {
      unsigned char* buf = smem + (step & 1) * SCB;
      const bool latent = step >= 4;
      const int ci = latent ? (b * 256 + (dir ? 255 - (step - 4) : (step - 4))) : (512 + b * 4 + (dir ? 3 - step : step));
      if (tid >= 64) {
        if (step + 1 < 260) { STG_STORE(10, smem + ((step + 1) & 1) * SCB) }
        if (step + 2 < 260) {
          const int s2 = step + 2;
          const int cin = (s2 >= 4) ? (b * 256 + (dir ? 255 - (s2 - 4) : (s2 - 4))) : (512 + b * 4 + (dir ? 3 - s2 : s2));
          STG_LOAD(10, tid - 64, NT - 64, cin)
        }
      } else {
        const float* scl = (const float*)(buf + SC_S);
#define FRAG(base, stride, mt, s) ld2x8((base) + (16 * (mt) + c) * (stride) + (32 * (s) + 4 * g) * 2, (base) + (16 * (mt) + c) * (stride) + (32 * (s) + 16 + 4 * g) * 2)
        bf16x8 Sb[4];
#pragma unroll
        for (int s = 0; s < 4; ++s) Sb[s] = pack8(S[2 * s], S[2 * s + 1]);
        bf16x8 kf[2][4], tf[4][2];
#pragma unroll
        for (int mt = 0; mt < 2; ++mt)
#pragma unroll
          for (int s = 0; s < 4; ++s) kf[mt][s] = FRAG(buf + SC_K, 272, mt, s);
        const float gl = scl[192];
#pragma unroll
        for (int mt = 0; mt < 4; ++mt)
#pragma unroll
          for (int s = 0; s < 2; ++s) tf[mt][s] = FRAG(buf + SC_T, 144, mt, s);
        __builtin_amdgcn_sched_barrier(0);
        f32x4 R[4];
#pragma unroll
        for (int hf = 0; hf < 2; ++hf) {
#pragma unroll
          for (int m2 = 0; m2 < 2; ++m2) {
            const int mt = 2 * hf + m2;
            f32x4 acc = (f32x4){0.f, 0.f, 0.f, 0.f};
#pragma unroll
            for (int s = 0; s < 4; ++s) acc = __builtin_amdgcn_mfma_f32_16x16x32_bf16(kf[m2][s], Sb[s], acc, 0, 0, 0);
#pragma unroll
            for (int r_ = 0; r_ < 4; ++r_) {
              const int pp = 16 * mt + 4 * g + r_;
              R[mt][r_] = scl[128 + pp] * (bf2f(*(const bf16_t*)(buf + SC_V + pp * 32 + c * 2)) - scl[pp] * acc[r_]);
            }
          }
          __builtin_amdgcn_sched_barrier(0);
#pragma unroll
          for (int m2 = 0; m2 < 2; ++m2)
#pragma unroll
            for (int s = 0; s < 4; ++s) kf[m2][s] = hf == 0 ? FRAG(buf + SC_K, 272, 2 + m2, s) : FRAG(buf + SC_Q, 272, m2, s);
          __builtin_amdgcn_sched_barrier(0);
        }
        bf16x8 Rb[2];
        Rb[0] = pack8(R[0], R[1]); Rb[1] = pack8(R[2], R[3]);
        f32x4 VN[4];
#pragma unroll
        for (int mt = 0; mt < 4; ++mt) {
          f32x4 acc = (f32x4){0.f, 0.f, 0.f, 0.f};
#pragma unroll
          for (int s = 0; s < 2; ++s) acc = __builtin_amdgcn_mfma_f32_16x16x32_bf16(tf[mt][s], Rb[s], acc, 0, 0, 0);
          VN[mt] = acc;
        }
#pragma unroll
        for (int mt = 0; mt < 4; ++mt)
#pragma unroll
          for (int s = 0; s < 2; ++s) tf[mt][s] = FRAG(buf + SC_A, 144, mt, s);
        __builtin_amdgcn_sched_barrier(0);
        if (latent) {
          bf16x8 Vb[2];
          Vb[0] = pack8(VN[0], VN[1]); Vb[1] = pack8(VN[2], VN[3]);
#pragma unroll
          for (int mt = 0; mt < 4; ++mt) {
            if (mt == 2) {
#pragma unroll
              for (int m2 = 0; m2 < 2; ++m2)
#pragma unroll
                for (int s = 0; s < 4; ++s) kf[m2][s] = FRAG(buf + SC_Q, 272, 2 + m2, s);
              __builtin_amdgcn_sched_barrier(0);
            }
            f32x4 acc = (f32x4){0.f, 0.f, 0.f, 0.f};
#pragma unroll
            for (int s = 0; s < 4; ++s) acc = __builtin_amdgcn_mfma_f32_16x16x32_bf16(kf[mt & 1][s], Sb[s], acc, 0, 0, 0);
#pragma unroll
            for (int r_ = 0; r_ < 4; ++r_) acc[r_] *= scl[16 * mt + 4 * g + r_];
#pragma unroll
            for (int s = 0; s < 2; ++s) acc = __builtin_amdgcn_mfma_f32_16x16x32_bf16(tf[mt][s], Vb[s], acc, 0, 0, 0);
#pragma unroll
            for (int r_ = 0; r_ < 4; ++r_) {
              const int pp = 16 * mt + 4 * g + r_;
              const size_t r = (size_t)(ci * 64 + (dir ? 63 - pp : pp));
              Od[r * 1024 + h * 128 + slice * 16 + c] = f2bf(acc[r_]);
            }
          }
        }
#pragma unroll
        for (int mt = 0; mt < 4; ++mt)
#pragma unroll
          for (int r_ = 0; r_ < 4; ++r_) VN[mt][r_] *= scl[64 + 16 * mt + 4 * g + r_];
        bf16x8 Wb[2];
        Wb[0] = pack8(VN[0], VN[1]); Wb[1] = pack8(VN[2], VN[3]);
#define KTFRAG(m8, s) (dir == 0 ? ld2x8(buf + SC_KT + (16 * (m8) + c) * 144 + (32 * (s) + 4 * g) * 2, buf + SC_KT + (16 * (m8) + c) * 144 + (32 * (s) + 16 + 4 * g) * 2) \
                                : ld2x8r(buf + SC_KT + (16 * (m8) + c) * 144 + (60 - 32 * (s) - 4 * g) * 2, buf + SC_KT + (16 * (m8) + c) * 144 + (44 - 32 * (s) - 4 * g) * 2))
#pragma unroll
        for (int hf = 0; hf < 2; ++hf) {
#pragma unroll
          for (int m4 = 0; m4 < 4; ++m4)
#pragma unroll
            for (int s = 0; s < 2; ++s) kf[m4 >> 1][2 * (m4 & 1) + s] = KTFRAG(4 * hf + m4, s);
          __builtin_amdgcn_sched_barrier(0);
#pragma unroll
          for (int m4 = 0; m4 < 4; ++m4) {
            f32x4 acc = S[4 * hf + m4] * gl;
#pragma unroll
            for (int s = 0; s < 2; ++s) acc = __builtin_amdgcn_mfma_f32_16x16x32_bf16(kf[m4 >> 1][2 * (m4 & 1) + s], Wb[s], acc, 0, 0, 0);
            S[4 * hf + m4] = acc;
          }
        }
#undef KTFRAG
#undef FRAG
      }
      asm volatile("s_waitcnt lgkmcnt(0)" ::: "memory");
      __builtin_amdgcn_s_barrier();
      asm volatile("" ::: "memory");
    }
    __syncthreads();
  }
}

DEV void gdn_out(const Params& p) {
  const bf16_t* O0 = (const bf16_t*)(PWS() + OFF_H); const bf16_t* O1 = (const bf16_t*)(PWS() + OFF_FILT);
  const bf16_t* Uz = (const bf16_t*)(PWS() + OFF_RA) + 3 * GD_U1;
  bf16_t* Y = (bf16_t*)(PWS() + OFF_PT);
  const float* NG = PIN(I_GDNORMG);
  const int tid = TIDX(), lane = tid & 63, wave = tid >> 6;
  for (int row = BIDX() * 8 + wave; row < TL; row += GDIM() * 8) {
    float a[16], b[16], z[16];
    { const uint4 x = *(const uint4*)(O0 + (size_t)row * 1024 + lane * 16), y = *(const uint4*)(O0 + (size_t)row * 1024 + lane * 16 + 8); unpack16(x, y, a); }
    { const uint4 x = *(const uint4*)(O1 + (size_t)row * 1024 + lane * 16), y = *(const uint4*)(O1 + (size_t)row * 1024 + lane * 16 + 8); unpack16(x, y, b); }
    { const uint4 x = *(const uint4*)(Uz + (size_t)row * 1024 + lane * 16), y = *(const uint4*)(Uz + (size_t)row * 1024 + lane * 16 + 8); unpack16(x, y, z); }
    float ss = 0.f;
#pragma unroll
    for (int i = 0; i < 16; ++i) { a[i] += b[i]; ss += a[i] * a[i]; }
    ss += SHX(ss, 1); ss += SHX(ss, 2); ss += SHX(ss, 4);
    const float inv = rsqrtf(ss * (1.f / 128.f) + 1e-6f);
    float ng[16]; load16f(NG + (lane & 7) * 16, ng);
#pragma unroll
    for (int i = 0; i < 16; ++i) a[i] = a[i] * inv * ng[i] * silu_f(z[i]);
    store16bf(Y + (size_t)row * 1024 + lane * 16, a);
  }
}
constexpr int N_PHASES = 39;

#define GEMM1(A, Bt, C, bias, M, N, K, lda, ldb, ldc, mode) gemm_phase(p, (const bf16_t*)(A), (const bf16_t*)(Bt), (void*)(C), (bias), (M), (N), (K), (lda), (ldb), (ldc), 1, (mode), 0L, 0L, 0L)
#define GEMMB(A, Bt, C, bias, M, N, K, lda, ldb, ldc, mode, nb, sA, sB, sC) gemm_phase(p, (const bf16_t*)(A), (const bf16_t*)(Bt), (void*)(C), (bias), (M), (N), (K), (lda), (ldb), (ldc), (nb), (mode), (long)(sA), (long)(sB), (long)(sC))

DEV void peer_phase(const Params& p, int layer, int sub, int nrows, int nrows_next) {
  unsigned char* ws = PWS();
  if (sub == 0) {
    REP(1) { GEMM1(ws + OFF_H, ws + OFF_WQK + (size_t)layer * 2048 * 1024 * 2, ws + OFF_RA, (const float*)nullptr, nrows, 2048, 1024, 1024, 1024, 0, 2); __syncthreads(); }
    REP(4) peer_tables(p, layer, nrows);
  } else if (sub == 1) { REP(4) peer_route(p, nrows); }
  else { REP(0) peer_expert(p, layer, nrows, nrows_next, DRY(0)); }
}

DEV void hyena_phase(const Params& p, int layer, int j, int sub, int nrows, bool with_ctx) {
  unsigned char* ws = PWS();
  switch (sub) {
    case 0:
      REP(1) { GEMM1(ws + OFF_H, ws + OFF_W_HYIN + (size_t)j * 3072 * 1024 * 2, ws + OFF_RA, PIN(I_HYINB) + j * 3072, nrows, 3072, 1024, 1024, 1024, 3072, 1); __syncthreads(); }
      if (j == 1) { REP(6) hyena_filter(p, 1, false); }
      break;
    case 1: REP(4) hy_prep(p, j, with_ctx); break;
    case 2: REP(2) hy_fft(p, j, with_ctx); break;
    case 3: REP(4) cm_to_tok(p, (const float*)(ws + OFF_RA), (const bf16_t*)(ws + OFF_RB), (bf16_t*)(ws + OFF_H), with_ctx); break;
    case 4:
      REP(1) { GEMM1(ws + OFF_H, ws + OFF_W_HYOUT + (size_t)j * 1024 * 1024 * 2, ws + OFF_RC, PIN(I_HYOUTB) + j * 1024, nrows, 1024, 1024, 1024, 1024, 1024, 1); __syncthreads(); }
      break;
    default: REP(5) post_mixer(p, layer, (const bf16_t*)(ws + OFF_RC), nrows, DRY(5)); break;
  }
}

DEV void run_phase(const Params& p, int ph) {
  unsigned char* ws = PWS();
  if (ph == 0) {
    REP(6) {
    const int skip_b = (GDIM() >= 64) ? 4 : 0;
    mod_gemv(p, skip_b); __syncthreads();
    weight_convert(p, skip_b); __syncthreads();
    fold_wqk(p); __syncthreads();
    hyena_filter(p, 0, true); __syncthreads();
    }
  } else if (ph == 1) {
    REP(6) init_phase(p);
  } else if (ph < 11) {
    const int s = ph - 2;
    if (s < 6) hyena_phase(p, 0, 0, s, TT, true); else peer_phase(p, 0, s - 6, TT, TT);
  } else if (ph < 21) {
    const int s = ph - 11;
    switch (s) {
      case 0: {
        REP(1) {
        GEMMB(ws + OFF_H, ws + OFF_W_GDIN, ws + OFF_RA, (const float*)nullptr, TT, 1024, 1024, 1024, 1024, 1024, 1, 4, 0, 1024 * 1024, GD_U1);
        GEMM1(ws + OFF_H, ws + OFF_W_GDAB, ws + OFF_GD_AB, (const float*)nullptr, TT, 256, 1024, 1024, 1024, 256, 0);
        __syncthreads(); }
      } break;
      case 1: REP(3) gdn_conv(p); break;
      case 2: REP(7) gdn_prep(p); break;
      case 3: REP(8) gdn_scan(p); break;
      case 4: REP(4) gdn_out(p); break;
      case 5: REP(1) { GEMM1(ws + OFF_PT, ws + OFF_W_GDOUT, ws + OFF_RB, (const float*)nullptr, TL, 1024, 1024, 1024, 1024, 1024, 1); __syncthreads(); } break;
      case 6: REP(5) post_mixer(p, 1, (const bf16_t*)(ws + OFF_RB), TL, DRY(5)); break;
      default: peer_phase(p, 1, s - 7, TL, TL); break;
    }
  } else if (ph < 30) {
    const int s = ph - 21;
    switch (s) {
      case 0: {
        REP(1) { GEMMB(ws + OFF_H, ws + OFF_W_DFT, ws + OFF_RA, (const float*)nullptr, TL, 256, 256, 1024, 256, 1024, 1, 4, 256, 0, 256); __syncthreads(); }
      } break;
      case 1: REP(4) fn_transpose(p); break;
      case 2: REP(2) fn_fft(p); break;
      case 3: REP(4) cm_to_tok(p, (const float*)(ws + OFF_RA), nullptr, (bf16_t*)(ws + OFF_H), false); break;
      case 4: REP(1) { GEMM1(ws + OFF_H, ws + OFF_W_FNOUT, ws + OFF_RC, PIN(I_FNOUTB), TL, 1024, 1024, 1024, 1024, 1024, 1); __syncthreads(); } break;
      case 5: REP(5) post_mixer(p, 2, (const bf16_t*)(ws + OFF_RC), TL, DRY(5)); break;
      default: peer_phase(p, 2, s - 6, TL, TL); break;
    }
  } else {
    const int s = ph - 30;
    if (s < 6) hyena_phase(p, 3, 1, s, TL, false); else peer_phase(p, 3, s - 6, TL, TL);
  }
}

DEV void ptab_init(const Params& p) {
  if (threadIdx.x == 0) {
#pragma unroll
    for (int i = 0; i < 31; ++i) g_ptab[i] = (unsigned long long)p.in[i];
    g_ptab[31] = (unsigned long long)p.out; g_ptab[32] = (unsigned long long)p.ws; g_ptab[33] = 0ull;
  }
  __syncthreads();
}
#if N_LAUNCH_MODE == 1
template <int PH> DEV void run_seq(const Params& p, cg::grid_group& grid, const XcdBarrier& xb) {
  run_phase(p, PH);
  if constexpr (PH + 1 < N_PHASES) {
    if constexpr (PH == 0) grid.sync();
    else { xcd_barrier(xb, p.ph_lo); if (BARRIER2) xcd_barrier(xb, p.ph_lo); }
    run_seq<PH + 1>(p, grid, xb);
  }
}
__global__ void __launch_bounds__(512) mega(Params p0) {
  cg::grid_group grid = cg::this_grid();
  if (threadIdx.x == 0) g_xbwords = make_uint4(0u, 0u, 0u, 0u);
  ptab_init(p0);
  if (blockIdx.x == 0) {
    unsigned* bar0 = (unsigned*)(p0.ws + OFF_BAR);
    for (int i = (int)threadIdx.x; i < 4096; i += NT) __hip_atomic_store(&bar0[i], 0u, __ATOMIC_RELAXED, __HIP_MEMORY_SCOPE_AGENT);
  }
  Params p; p.ph_lo = __builtin_amdgcn_readfirstlane((int)(threadIdx.x >> 6)); p.ph_hi = 0;
  run_phase(p, 0);
  grid.sync();
  const XcdBarrier xb = xcd_barrier_post((unsigned*)(p0.ws + OFF_BAR), (volatile LAS unsigned*)&g_xbwords);
  run_seq<1>(p, grid, xb);
}
#else
template <int PH> __global__ void __launch_bounds__(512) mega_one(Params p0) {
  ptab_init(p0);
  Params p; p.ph_lo = __builtin_amdgcn_readfirstlane((int)(threadIdx.x >> 6)); p.ph_hi = 0;
  run_phase(p, PH);
}
typedef void (*kern_t)(Params);
template <int PH> struct KTab { static void fill(kern_t* t) { t[PH] = mega_one<PH>; KTab<PH - 1>::fill(t); } };
template <> struct KTab<-1> { static void fill(kern_t*) {} };
#endif

extern "C" void kernel_launch(void* const* d_in, const int* in_sizes, int n_in, void* d_out, int out_size, void* d_ws, size_t ws_size, hipStream_t stream) {
  static int grid_blocks = 0;
#if N_LAUNCH_MODE != 1
  static kern_t ktab[N_PHASES];
#endif
  if (!grid_blocks) {
    int dev = 0, cus = 0, per_cu = 0;
    (void)hipGetDevice(&dev);
    (void)hipDeviceGetAttribute(&cus, hipDeviceAttributeMultiprocessorCount, dev);
#if N_LAUNCH_MODE == 1
    (void)hipFuncSetAttribute((const void*)mega, hipFuncAttributeMaxDynamicSharedMemorySize, LDS_BYTES);
    (void)hipOccupancyMaxActiveBlocksPerMultiprocessor(&per_cu, (const void*)mega, NT, LDS_BYTES);
    if (per_cu < 1) { fprintf(stderr, "occupancy query says %d blocks/CU\n", per_cu); per_cu = 1; }
#else
    KTab<N_PHASES - 1>::fill(ktab);
    for (int i = 0; i < N_PHASES; ++i) (void)hipFuncSetAttribute((const void*)ktab[i], hipFuncAttributeMaxDynamicSharedMemorySize, LDS_BYTES);
#endif
    grid_blocks = cus;
    if (ws_size < WS_END || n_in != 31) fprintf(stderr, "kernel_launch: unexpected ws_size %zu (need %zu) or n_in %d\n", ws_size, (size_t)WS_END, n_in);
  }
  Params p{};
  for (int i = 0; i < 31; ++i) p.in[i] = (const float*)d_in[i];
  p.out = (float*)d_out; p.ws = (unsigned char*)d_ws;
#if N_LAUNCH_MODE == 1
  p.ph_lo = 0; p.ph_hi = N_PHASES;
  void* args[] = {&p};
  hipError_t e = hipLaunchCooperativeKernel((const void*)mega, dim3(grid_blocks), dim3(NT), args, LDS_BYTES, stream);
  if (e != hipSuccess) fprintf(stderr, "cooperative launch failed: %s\n", hipGetErrorString(e));
#else
  p.ph_lo = 0; p.ph_hi = 0;
  for (int ph = 0; ph < N_PHASES; ++ph) {
    hipLaunchKernelGGL(ktab[ph], dim3(grid_blocks), dim3(NT), LDS_BYTES, stream, p);
  }
#endif
}
```

```cpp
#include <hip/hip_runtime.h>
#include <hip/hip_cooperative_groups.h>
#include <cstdio>
#include <cstdint>
namespace cg = cooperative_groups;

#ifndef KO_MASK
#define KO_MASK 0
#endif
#ifndef DUP_MASK
#define DUP_MASK 0
#endif
#define REP(bit) for (int rep_ = 0; rep_ < (((DUP_MASK) >> (bit)) & 1) + 1; ++rep_)
#define DRY(bit) ((((DUP_MASK) >> (bit)) & 1) && rep_ == 0)
#ifndef EXPERT_L2PROBE
#define EXPERT_L2PROBE 0
#endif
#ifndef EXPERT_VALU2
#define EXPERT_VALU2 0
#endif
#ifndef EXPERT_BYTES2
#define EXPERT_BYTES2 0
#endif
#ifndef BARRIER2
#define BARRIER2 0
#endif
#ifndef N_LAUNCH_MODE
#define N_LAUNCH_MODE 1
#endif

typedef unsigned short bf16_t;
typedef short bf16x8 __attribute__((ext_vector_type(8)));
typedef float f32x4 __attribute__((ext_vector_type(4)));
typedef int v8i32 __attribute__((ext_vector_type(8)));
#define DEV __device__ __forceinline__

constexpr int D = 1024, LSEQ = 16384, TL = 32768, CTXL = 256, TT = 33280;
constexpr int NT = 512;
constexpr float DN_ALPHA = 1.6817928305074290f;
constexpr float LN_EPS = 1e-5f;
constexpr int LDS_BYTES = 150 * 1024;

constexpr size_t AL(size_t x) { return (x + 255) & ~(size_t)255; }
constexpr size_t SZ_X = (size_t)TT * D * 4;
constexpr size_t OFF_X = 0;
constexpr size_t OFF_MOD = OFF_X + AL(SZ_X);
constexpr size_t OFF_W_HYIN = OFF_MOD + AL((size_t)4 * 3 * 6144 * 4);
constexpr size_t OFF_W_HYOUT = OFF_W_HYIN + AL((size_t)2 * 3072 * 1024 * 2);
constexpr size_t OFF_W_GDIN = OFF_W_HYOUT + AL((size_t)2 * 1024 * 1024 * 2);
constexpr size_t OFF_W_GDAB = OFF_W_GDIN + AL((size_t)4096 * 1024 * 2);
constexpr size_t OFF_W_GDOUT = OFF_W_GDAB + AL((size_t)256 * 1024 * 2);
constexpr size_t OFF_W_FNOUT = OFF_W_GDOUT + AL((size_t)1024 * 1024 * 2);
constexpr size_t OFF_W_DFT = OFF_W_FNOUT + AL((size_t)1024 * 1024 * 2);
constexpr size_t OFF_WQK = OFF_W_DFT + AL((size_t)256 * 256 * 2);
constexpr size_t OFF_H = OFF_WQK + AL((size_t)4 * 2048 * 1024 * 2);
constexpr size_t OFF_PT = OFF_H + AL((size_t)TT * D * 2);
constexpr size_t SZ_PT1 = (size_t)16384 * 1024 * 2;
constexpr size_t OFF_FILT = OFF_PT + AL(2 * SZ_PT1);
constexpr size_t SZ_FILT1 = (size_t)1024 * 16384 * 4;
constexpr size_t OFF_RA = OFF_FILT + AL(2 * SZ_FILT1 + 2 * (size_t)1024 * 256 * 4);
constexpr size_t SZ_RA = (size_t)4 * TT * D * 2;
constexpr size_t OFF_RB = OFF_RA + AL(SZ_RA);
constexpr size_t SZ_RB = (size_t)TT * 3072 * 2;
constexpr size_t OFF_RC = OFF_RB + AL(SZ_RB);
constexpr size_t SZ_RC = (size_t)TT * D * 4;
constexpr size_t OFF_BAR = OFF_RC + AL(SZ_RC);
constexpr size_t OFF_PE = OFF_BAR + 16384;
constexpr size_t WS_END = OFF_PE + (size_t)320 * 512 * 4;

struct Params {
  const float* in[31];
  float* out;
  unsigned char* ws;
  int ph_lo, ph_hi;
};
enum { I_X = 0, I_C, I_CTX, I_CCTX, I_ADAW, I_ADAB, I_LNG, I_LNB, I_PKWQ, I_PKKEYS, I_PKU, I_PKV,
       I_HYINW, I_HYINB, I_HYCONV, I_HYFW1, I_HYFB1, I_HYFW2, I_HYFB2, I_HYFW3, I_HYSKIP, I_HYOUTW, I_HYOUTB,
       I_GDINW, I_GDCONV, I_GDALOG, I_GDDTB, I_GDNORMG, I_GDOUTW, I_FNOUTW, I_FNOUTB };

extern __shared__ __attribute__((aligned(16))) unsigned char smem[];
__shared__ __attribute__((aligned(16))) unsigned long long g_ptab[34];
__device__ __forceinline__ unsigned long long ld_u64_uniform(int i) {
  const unsigned long long v = ((const volatile __attribute__((address_space(3))) unsigned long long*)g_ptab)[i];
  const unsigned lo = __builtin_amdgcn_readfirstlane((unsigned)v), hi = __builtin_amdgcn_readfirstlane((unsigned)(v >> 32));
  return ((unsigned long long)hi << 32) | lo;
}
__device__ __forceinline__ int tidx_of(int wave_u) {
  int l; asm volatile("v_mbcnt_lo_u32_b32 %0, -1, 0\n\tv_mbcnt_hi_u32_b32 %0, -1, %0" : "=v"(l));
  return (wave_u << 6) | l;
}
#define TIDX() tidx_of(p.ph_lo)
__device__ __forceinline__ int BIDX() { int t = blockIdx.x; asm volatile("" : "+s"(t)); return t; }
__device__ __forceinline__ int GDIM() { int t = gridDim.x; asm volatile("" : "+s"(t)); return t; }
#define GAS __attribute__((address_space(1)))
#define PIN(i) ((const float*)(const GAS float*)ld_u64_uniform(i))
#define POUT() ((float*)(GAS float*)ld_u64_uniform(31))
#define PWS() ((unsigned char*)(GAS unsigned char*)ld_u64_uniform(32))

DEV bf16_t f2bf(float f) { unsigned u = __float_as_uint(f); u += 0x7fffu + ((u >> 16) & 1u); return (bf16_t)(u >> 16); }
DEV float bf2f(bf16_t h) { return __uint_as_float(((unsigned)h) << 16); }
DEV unsigned pack2(float lo, float hi) { return (unsigned)f2bf(lo) | ((unsigned)f2bf(hi) << 16); }
DEV float bflo(unsigned u) { return __uint_as_float(u << 16); }
DEV float bfhi(unsigned u) { return __uint_as_float(u & 0xffff0000u); }
DEV float silu_f(float x) { return x / (1.f + __expf(-x)); }
DEV float gelu_tanh(float x) { float u = 0.7978845608028654f * (x + 0.044715f * x * x * x); float t = 1.f - 2.f / (1.f + __expf(2.f * u)); return 0.5f * x * (1.f + t); }
DEV float shfl_idx_f(float v, int src) { return __uint_as_float((unsigned)__builtin_amdgcn_ds_bpermute(src << 2, (int)__float_as_uint(v))); }
#define SHX(x, m) shfl_idx_f((x), (lane) ^ (m))
DEV float wave_sum(float v, int lane) {
#pragma unroll
  for (int o = 32; o > 0; o >>= 1) v += SHX(v, o);
  return v;
}
DEV void unpack16(const uint4& a, const uint4& b, float (&f)[16]) {
  f[0] = bflo(a.x); f[1] = bfhi(a.x); f[2] = bflo(a.y); f[3] = bfhi(a.y); f[4] = bflo(a.z); f[5] = bfhi(a.z); f[6] = bflo(a.w); f[7] = bfhi(a.w);
  f[8] = bflo(b.x); f[9] = bfhi(b.x); f[10] = bflo(b.y); f[11] = bfhi(b.y); f[12] = bflo(b.z); f[13] = bfhi(b.z); f[14] = bflo(b.w); f[15] = bfhi(b.w);
}
DEV void load16f(const float* p, float (&f)[16]) {
#pragma unroll
  for (int i = 0; i < 4; ++i) { float4 v = *(const float4*)(p + 4 * i); f[4 * i] = v.x; f[4 * i + 1] = v.y; f[4 * i + 2] = v.z; f[4 * i + 3] = v.w; }
}
DEV void store16f(float* p, const float (&f)[16]) {
#pragma unroll
  for (int i = 0; i < 4; ++i) *(float4*)(p + 4 * i) = make_float4(f[4 * i], f[4 * i + 1], f[4 * i + 2], f[4 * i + 3]);
}
DEV void store16bf(bf16_t* p, const float (&f)[16]) {
  uint4 a, b;
  a.x = pack2(f[0], f[1]); a.y = pack2(f[2], f[3]); a.z = pack2(f[4], f[5]); a.w = pack2(f[6], f[7]);
  b.x = pack2(f[8], f[9]); b.y = pack2(f[10], f[11]); b.z = pack2(f[12], f[13]); b.w = pack2(f[14], f[15]);
  *(uint4*)p = a; *(uint4*)(p + 8) = b;
}
DEV void load16bf(const bf16_t* p, float (&f)[16]) { const uint4 a = *(const uint4*)p, b = *(const uint4*)(p + 8); unpack16(a, b, f); }
DEV int modrow_of(int r) { return r < TL ? (r >> 14) : 2; }
DEV const float* mod_ptr(const float* MOD, int layer, int mr, int comp) { return MOD + ((size_t)(layer * 3 + mr) * 6 + comp) * 1024; }

DEV void ln_row(float (&v)[16], const float* g, const float* b, int lane) {
  float s = 0.f;
#pragma unroll
  for (int i = 0; i < 16; ++i) s += v[i];
  const float mu = wave_sum(s, lane) * (1.f / 1024.f);
  float q = 0.f;
#pragma unroll
  for (int i = 0; i < 16; ++i) { v[i] -= mu; q += v[i] * v[i]; }
  const float rs = rsqrtf(wave_sum(q, lane) * (1.f / 1024.f) + LN_EPS);
  float gg[16], bb[16];
  load16f(g + lane * 16, gg); load16f(b + lane * 16, bb);
#pragma unroll
  for (int i = 0; i < 16; ++i) v[i] = v[i] * rs * gg[i] + bb[i];
}

#define XB_TMO      128
#define XB_XCNT(j)  (256  + 64 * (j))
#define XB_XSUB(j)  (1280 + 64 * (j))
#define XB_XGEN(j)  (2304 + 64 * (j))
#define XB_TOP      3328
#define XB_TOPGEN   3392
#define XCD_BAR_WORDS 3456
#define XB_SPIN_CAP (1u << 22)
#define LAS __attribute__((address_space(3)))
DEV unsigned xb_ld(unsigned* p) { return __hip_atomic_load(p, __ATOMIC_RELAXED, __HIP_MEMORY_SCOPE_AGENT); }
DEV unsigned xb_add(unsigned* p, unsigned v) { return __hip_atomic_fetch_add(p, v, __ATOMIC_RELAXED, __HIP_MEMORY_SCOPE_AGENT); }
DEV unsigned xb_xcc_id() { return (unsigned)__builtin_amdgcn_s_getreg((3 << 11) | 20) & 0xFu; }
#define XB_SPIN(cond, bar) do { unsigned _sp = 0; while (cond) { __builtin_amdgcn_s_sleep(1); \
    if ((++_sp & 255u) == 0u) { if (xb_ld(&(bar)[XB_TMO])) break; if (_sp > XB_SPIN_CAP) { atomicAdd(&(bar)[XB_TMO], 1u); break; } } } } while (0)
struct XcdBarrier { unsigned* bar; unsigned x; volatile LAS unsigned* st; };
__shared__ __attribute__((aligned(16))) uint4 g_xbwords;
DEV XcdBarrier xcd_barrier_post(unsigned* bar, volatile LAS unsigned* st) {
  XcdBarrier b; b.bar = bar; b.x = xb_xcc_id(); b.st = st;
  if (threadIdx.x == 0) (void)xb_add(&bar[XB_XCNT(b.x)], 1u);
  return b;
}
DEV void xcd_barrier_complete(unsigned* bar, unsigned x, unsigned& nloc, unsigned& nx) {
  const unsigned G = gridDim.x * gridDim.y * gridDim.z;
  unsigned sum, cnt, mine, sp = 0u;
  for (;;) {
    sum = 0u; cnt = 0u; mine = 0u;
#pragma unroll
    for (unsigned j = 0; j < 16; ++j) { const unsigned c = xb_ld(&bar[XB_XCNT(j)]); sum += c; cnt += (c > 0u) ? 1u : 0u; mine = (j == x) ? c : mine; }
    if (sum == G) break;
    __builtin_amdgcn_s_sleep(1);
    if ((++sp & 255u) == 0u) { if (xb_ld(&bar[XB_TMO])) break; if (sp > XB_SPIN_CAP) { atomicAdd(&bar[XB_TMO], 1u); break; } }
  }
  nloc = mine > 0u ? mine : 1u; nx = cnt > 0u ? cnt : 1u;
}
DEV void xcd_barrier(const XcdBarrier& b, int wave_u) {
  asm volatile("s_waitcnt vmcnt(0)" ::: "memory");
  __syncthreads();
  if (tidx_of(wave_u) == 0) {
    unsigned* bar = b.bar;
    __builtin_amdgcn_s_waitcnt(0);
    unsigned nloc = b.st[0], nx = b.st[1];
    if (nloc == 0u) { xcd_barrier_complete(bar, b.x, nloc, nx); b.st[0] = nloc; b.st[1] = nx; }
    const unsigned old = xb_add(&bar[XB_XSUB(b.x)], 1u);
    const unsigned gen = old / nloc;
    if (old + 1u == (gen + 1u) * nloc) {
      __builtin_amdgcn_fence(__ATOMIC_RELEASE, "agent");
      asm volatile("s_waitcnt vmcnt(0)" ::: "memory");
      const unsigned og = xb_add(&bar[XB_TOP], 1u);
      const unsigned tg = og / nx;
      if (og + 1u == (tg + 1u) * nx) xb_add(&bar[XB_TOPGEN], 1u);
      else XB_SPIN(xb_ld(&bar[XB_TOPGEN]) == tg, bar);
      __builtin_amdgcn_fence(__ATOMIC_ACQUIRE, "agent");
      xb_add(&bar[XB_XGEN(b.x)], 1u);
      asm volatile("s_waitcnt vmcnt(0)" ::: "memory");
    } else {
      XB_SPIN(xb_ld(&bar[XB_XGEN(b.x)]) == gen, bar);
      __builtin_amdgcn_fence(__ATOMIC_ACQUIRE, "agent");
      asm volatile("s_waitcnt vmcnt(0)" ::: "memory");
    }
  }
  __syncthreads();
}
#define CEX(a, b) { const unsigned _mx = (a) > (b) ? (a) : (b); const unsigned _mn = (a) > (b) ? (b) : (a); (a) = _mx; (b) = _mn; }
DEV unsigned fkey(float x) { unsigned u = __float_as_uint(x); return (u & 0x80000000u) ? ~u : (u | 0x80000000u); }
DEV float keyf(unsigned k) { unsigned u = (k & 0x80000000u) ? (k & 0x7fffffffu) : ~k; return __uint_as_float(u); }
DEV void sort16_desc(unsigned (&k)[16]) {
#pragma unroll
  for (int size = 2; size <= 16; size <<= 1) {
#pragma unroll
    for (int stride = size >> 1; stride > 0; stride >>= 1) {
#pragma unroll
      for (int i = 0; i < 16; ++i) {
        const int j = i ^ stride;
        if (j > i) {
          if ((i & size) == 0) { CEX(k[i], k[j]); } else { CEX(k[j], k[i]); }
        }
      }
    }
  }
}
DEV void merge16_desc(unsigned (&best)[16], const unsigned (&cur)[16]) {
#pragma unroll
  for (int i = 0; i < 16; ++i) best[i] = best[i] > cur[15 - i] ? best[i] : cur[15 - i];
#pragma unroll
  for (int stride = 8; stride > 0; stride >>= 1) {
#pragma unroll
    for (int i = 0; i < 16; ++i) { const int j = i ^ stride; if (j > i) { CEX(best[i], best[j]); } }
  }
}

DEV void gemm_phase(const Params& p, const bf16_t* gA, const bf16_t* gBt, void* gC, const float* gbias, const int gM, const int gN, const int gK, const int glda, const int gldb, const int gldc,
                    const int gnbatch, const int gmode, const long gsA, const long gsB, const long gsC) {
  const int tid = TIDX(), lane = tid & 63, wave = tid >> 6, wm = wave >> 1, wn = wave & 1;
  const int g = lane >> 4, c = lane & 15;
  const int MT = gM / 256, NTn = gN / 256, nk = gK / 32;
  unsigned char* sAb = smem;
  unsigned char* sBb = smem + 65536;
  const int drow = lane >> 2, dch = (lane & 3) ^ ((-((lane >> 4) & 3)) & 3);
  long offA[2], offB[2];
#pragma unroll
  for (int i = 0; i < 2; ++i) {
    const int row = (wave + 8 * i) * 16 + drow;
    offA[i] = (long)row * glda + dch * 8;
    const int sl = row & 127;
    const int src = (row & 128) + 32 * ((sl >> 2) & 3) + 4 * (sl >> 4) + (sl & 3);
    offB[i] = (long)src * gldb + dch * 8;
  }
  LAS unsigned char* lA = (LAS unsigned char*)sAb + wave * 1024;
  LAS unsigned char* lB = (LAS unsigned char*)sBb + wave * 1024;
#define G_DMA(pA_, pB_, buf, k0) { \
      _Pragma("unroll") for (int i_ = 0; i_ < 2; ++i_) __builtin_amdgcn_global_load_lds((const unsigned*)((pA_) + offA[i_] + (k0)), (LAS unsigned*)(lA + (buf) * 16384 + i_ * 8192), 16, 0, 0); \
      _Pragma("unroll") for (int i_ = 0; i_ < 2; ++i_) __builtin_amdgcn_global_load_lds((const unsigned*)((pB_) + offB[i_] + (k0)), (LAS unsigned*)(lB + (buf) * 16384 + i_ * 8192), 16, 0, 0); }
  const int nblk = GDIM(), xg = (nblk % 8 == 0) ? 8 : 1, xid = BIDX() % xg, jloc = BIDX() / xg, nloc_b = nblk / xg;
  const int per_mt = NTn * gnbatch, n_local = ((MT - xid + xg - 1) / xg) * per_mt;
#define G_TILE_DEC(l_, mt_, bt_, nt_) { const int mi_ = (l_) / per_mt, rem_ = (l_) % per_mt; mt_ = xid + xg * mi_; bt_ = rem_ / NTn; nt_ = rem_ % NTn; }
#define G_TILE_PTRS(l_, A_, B_) { int mt_, bt_, nt_; G_TILE_DEC(l_, mt_, bt_, nt_); \
      A_ = gA + (long)bt_ * gsA + (long)mt_ * 256 * glda; B_ = gBt + (long)bt_ * gsB + (long)nt_ * 256 * gldb; }
  const bool trail = wave >= 4;
  const bool stream = (gmode != 2);
  int cur = 0; bool started = false;
  for (int tile = jloc; tile < n_local; tile += nloc_b) {
    int mt, bt, nt; G_TILE_DEC(tile, mt, bt, nt);
    const bf16_t* A; const bf16_t* B; G_TILE_PTRS(tile, A, B);
    const bool has_next = stream && (tile + nloc_b < n_local);
    const bf16_t* An = A; const bf16_t* Bn = B;
    if (has_next) { G_TILE_PTRS(tile + nloc_b, An, Bn); }
    f32x4 acc[4][8];
#pragma unroll
    for (int i = 0; i < 4; ++i)
#pragma unroll
      for (int j = 0; j < 8; ++j) acc[i][j] = (f32x4){0.f, 0.f, 0.f, 0.f};
    if (!started) {
      cur = 0;
      G_DMA(A, B, 0, 0);
      G_DMA(A, B, 1, 32);
      G_DMA(A, B, 2, 64);
      asm volatile("s_waitcnt vmcnt(8)" ::: "memory");
      __builtin_amdgcn_s_barrier();
      if (trail) __builtin_amdgcn_s_barrier();
      started = stream;
    }
#pragma unroll 1
    for (int kt = 0; kt < nk; ++kt) {
      const int nx3 = (cur + 3) & 3;
      const bool more = (kt + 3 < nk) || has_next;
      if (kt + 3 < nk) { G_DMA(A, B, nx3, (kt + 3) * 32); }
      else if (has_next) { G_DMA(An, Bn, nx3, (kt + 3 - nk) * 32); }
      const int choff = ((g ^ ((-((c >> 2) & 3)) & 3)) << 4);
      const unsigned char* pa = sAb + cur * 16384 + (wm * 64 + c) * 64 + choff;
      const unsigned char* pb = sBb + cur * 16384 + (wn * 128 + c) * 64 + choff;
      bf16x8 af[4], bfr[8];
#pragma unroll
      for (int mi = 0; mi < 4; ++mi) af[mi] = *(const bf16x8*)(pa + mi * 16 * 64);
#pragma unroll
      for (int ni = 0; ni < 8; ++ni) bfr[ni] = *(const bf16x8*)(pb + ni * 16 * 64);
      if (more) { asm volatile("s_waitcnt vmcnt(8)" ::: "memory"); }
      else if (kt + 2 < nk) { asm volatile("s_waitcnt vmcnt(4)" ::: "memory"); }
      else { asm volatile("s_waitcnt vmcnt(0)" ::: "memory"); }
      asm volatile("s_waitcnt lgkmcnt(0)" ::: "memory");
      __builtin_amdgcn_sched_barrier(0);
      __builtin_amdgcn_s_barrier();
      __builtin_amdgcn_sched_barrier(0);
      __builtin_amdgcn_s_setprio(1);
#pragma unroll
      for (int mi = 0; mi < 4; ++mi)
#pragma unroll
        for (int ni = 0; ni < 8; ++ni) acc[mi][ni] = __builtin_amdgcn_mfma_f32_16x16x32_bf16(bfr[ni], af[mi], acc[mi][ni], 0, 0, 0);
      __builtin_amdgcn_s_setprio(0);
      __builtin_amdgcn_sched_barrier(0);
      __builtin_amdgcn_s_barrier();
      __builtin_amdgcn_sched_barrier(0);
      cur = (cur + 1) & 3;
    }
    if (!stream || !has_next) {
      if (!trail) __builtin_amdgcn_s_barrier();
      __syncthreads();
    }
    const int mloc = wm * 64 + c, nloc = wn * 128 + 32 * g;
    if (gmode == 0) {
      float* C = (float*)gC + (long)bt * gsC;
      const int n = nt * 256 + nloc;
#pragma unroll
      for (int mi = 0; mi < 4; ++mi) {
        const long m = (long)mt * 256 + mloc + mi * 16;
#pragma unroll
        for (int ni = 0; ni < 8; ++ni) {
          const float4 bv = gbias ? *(const float4*)(gbias + n + 4 * ni) : make_float4(0.f, 0.f, 0.f, 0.f);
          *(float4*)(C + m * gldc + n + 4 * ni) = make_float4(acc[mi][ni][0] + bv.x, acc[mi][ni][1] + bv.y, acc[mi][ni][2] + bv.z, acc[mi][ni][3] + bv.w);
        }
      }
    } else if (gmode == 1) {
      bf16_t* C = (bf16_t*)gC + (long)bt * gsC;
      const int n = nt * 256 + nloc;
#pragma unroll
      for (int mi = 0; mi < 4; ++mi) {
        const long m = (long)mt * 256 + mloc + mi * 16;
#pragma unroll
        for (int q = 0; q < 4; ++q) {
          const float4 b0 = gbias ? *(const float4*)(gbias + n + 8 * q) : make_float4(0.f, 0.f, 0.f, 0.f);
          const float4 b1 = gbias ? *(const float4*)(gbias + n + 8 * q + 4) : make_float4(0.f, 0.f, 0.f, 0.f);
          uint4 o;
          o.x = pack2(acc[mi][2 * q][0] + b0.x, acc[mi][2 * q][1] + b0.y); o.y = pack2(acc[mi][2 * q][2] + b0.z, acc[mi][2 * q][3] + b0.w);
          o.z = pack2(acc[mi][2 * q + 1][0] + b1.x, acc[mi][2 * q + 1][1] + b1.y); o.w = pack2(acc[mi][2 * q + 1][2] + b1.z, acc[mi][2 * q + 1][3] + b1.w);
          *(uint4*)(C + m * gldc + n + 8 * q) = o;
        }
      }
    } else {
      float* S = (float*)smem;
#pragma unroll 1
      for (int h = 0; h < 2; ++h) {
        if (wn == h) {
#pragma unroll
          for (int mi = 0; mi < 4; ++mi)
#pragma unroll
            for (int ni = 0; ni < 8; ++ni)
#pragma unroll
              for (int r = 0; r < 4; ++r) S[(mloc + mi * 16) * 129 + 32 * g + 4 * ni + r] = acc[mi][ni][r];
        }
        __syncthreads();
        if (tid < 256) {
          const float* row = S + tid * 129;
          unsigned best[16], cur16[16];
#pragma unroll
          for (int i = 0; i < 16; ++i) best[i] = (fkey(row[i]) & ~127u) | (unsigned)(127 - i);
          sort16_desc(best);
#pragma unroll
          for (int q = 1; q < 8; ++q) {
#pragma unroll
            for (int i = 0; i < 16; ++i) cur16[i] = (fkey(row[q * 16 + i]) & ~127u) | (unsigned)(127 - (q * 16 + i));
            sort16_desc(cur16);
            merge16_desc(best, cur16);
          }
          unsigned* dst = (unsigned*)gC + (((long)mt * 256 + tid) * (gN / 128) + (nt * 2 + h)) * 16;
#pragma unroll
          for (int i = 0; i < 4; ++i) *(uint4*)(dst + 4 * i) = make_uint4(best[4 * i], best[4 * i + 1], best[4 * i + 2], best[4 * i + 3]);
        }
        __syncthreads();
      }
    }
  }
#undef G_DMA
#undef G_TILE_PTRS
#undef G_TILE_DEC
}
DEV void mod_gemv(const Params& p, int skip_b) {
  const int bidx = BIDX() - skip_b, nblk = GDIM() - skip_b;
  if (bidx < 0) return;
  float* sc = (float*)smem;
  float* red = sc + 3 * 1024;
  const int tid = TIDX();
  for (int i = tid; i < 3072; i += NT) {
    const int r = i >> 10, k = i & 1023;
    const float v = (r < 2) ? PIN(I_C)[r * 1024 + k] : PIN(I_CCTX)[k];
    sc[i] = silu_f(v);
  }
  __syncthreads();
  float* MOD = (float*)(PWS() + OFF_MOD);
  const int col = tid & 31, ks = tid >> 5;
  for (int item = bidx; item < 4 * 192; item += nblk) {
    const int layer = item / 192, n0 = (item % 192) * 32;
    const float* W = PIN(I_ADAW) + (size_t)layer * 1024 * 6144 + n0 + col;
    float a0 = 0.f, a1 = 0.f, a2 = 0.f;
#pragma unroll 8
    for (int kk = 0; kk < 64; ++kk) {
      const int k = ks * 64 + kk;
      const float w = W[(size_t)k * 6144];
      a0 += sc[k] * w; a1 += sc[1024 + k] * w; a2 += sc[2048 + k] * w;
    }
    red[(ks * 3 + 0) * 32 + col] = a0; red[(ks * 3 + 1) * 32 + col] = a1; red[(ks * 3 + 2) * 32 + col] = a2;
    __syncthreads();
    if (tid < 96) {
      const int r = tid >> 5, cc = tid & 31;
      float s = PIN(I_ADAB)[layer * 6144 + n0 + cc];
#pragma unroll
      for (int q = 0; q < 16; ++q) s += red[(q * 3 + r) * 32 + cc];
      MOD[(size_t)(layer * 3 + r) * 6144 + n0 + cc] = s;
    }
    __syncthreads();
  }
}

DEV void wconv_tile(const Params& p, const float* src, int ld, int K, bf16_t* dst, int kt, int ntile) {
  float* tl = (float*)smem;
  const int tid = TIDX();
  {
    const int r = tid >> 4, c4 = (tid & 15) * 4;
#pragma unroll
    for (int h = 0; h < 2; ++h) {
      const int rr = r + 32 * h;
      const float4 v = *(const float4*)(src + (size_t)(kt * 64 + rr) * ld + ntile * 64 + c4);
      tl[rr * 65 + c4] = v.x; tl[rr * 65 + c4 + 1] = v.y; tl[rr * 65 + c4 + 2] = v.z; tl[rr * 65 + c4 + 3] = v.w;
    }
  }
  __syncthreads();
  {
    const int n = tid >> 3, k8 = (tid & 7) * 8;
    uint4 o;
    o.x = pack2(tl[(k8 + 0) * 65 + n], tl[(k8 + 1) * 65 + n]); o.y = pack2(tl[(k8 + 2) * 65 + n], tl[(k8 + 3) * 65 + n]);
    o.z = pack2(tl[(k8 + 4) * 65 + n], tl[(k8 + 5) * 65 + n]); o.w = pack2(tl[(k8 + 6) * 65 + n], tl[(k8 + 7) * 65 + n]);
    *(uint4*)(dst + (size_t)(ntile * 64 + n) * K + kt * 64 + k8) = o;
  }
  __syncthreads();
}

DEV void weight_convert(const Params& p, int skip_b) {
  const int bidx = BIDX() - skip_b, nblk = GDIM() - skip_b;
  if (bidx < 0) return;
  const int total = (48 + 48 + 16 + 16 + 64 + 16 + 16) * 16;
  for (int item = bidx; item < total; item += nblk) {
    int m, rem;
    if (item < 768) { m = 0; rem = item; }
    else if (item < 1536) { m = 1; rem = item - 768; }
    else if (item < 1792) { m = 2; rem = item - 1536; }
    else if (item < 2048) { m = 3; rem = item - 1792; }
    else if (item < 3072) { m = 4; rem = item - 2048; }
    else if (item < 3328) { m = 5; rem = item - 3072; }
    else { m = 6; rem = item - 3328; }
    const int kt = rem & 15, ntile = rem >> 4;
    const float* src; int ld; bf16_t* dst;
    switch (m) {
      case 0: case 1: src = PIN(I_HYINW) + (size_t)m * 1024 * 3072; ld = 3072; dst = (bf16_t*)(PWS() + OFF_W_HYIN) + (size_t)m * 3072 * 1024; break;
      case 2: case 3: src = PIN(I_HYOUTW) + (size_t)(m - 2) * 1024 * 1024; ld = 1024; dst = (bf16_t*)(PWS() + OFF_W_HYOUT) + (size_t)(m - 2) * 1024 * 1024; break;
      case 4: src = PIN(I_GDINW); ld = 4128; dst = (bf16_t*)(PWS() + OFF_W_GDIN); break;
      case 5: src = PIN(I_GDOUTW); ld = 1024; dst = (bf16_t*)(PWS() + OFF_W_GDOUT); break;
      default: src = PIN(I_FNOUTW); ld = 1024; dst = (bf16_t*)(PWS() + OFF_W_FNOUT); break;
    }
    wconv_tile(p, src, ld, 1024, dst, kt, ntile);
  }
  const size_t gtid = (size_t)bidx * NT + TIDX(), gsz = (size_t)nblk * NT;
  bf16_t* wab = (bf16_t*)(PWS() + OFF_W_GDAB);
  for (size_t i = gtid; i < (size_t)256 * 1024; i += gsz) {
    const int n = (int)(i >> 10), k = (int)(i & 1023);
    wab[i] = (n < 32) ? f2bf(PIN(I_GDINW)[(size_t)k * 4128 + 4096 + n]) : (bf16_t)0;
  }
  float* pe = (float*)(PWS() + OFF_PE);
  for (size_t i = gtid; i < (size_t)320 * 512; i += gsz) {
    const int r = (int)(i >> 9), dd = (int)(i & 511), jj = dd & 255;
    const float om = expf(-(float)jj * (9.210340371976184f / 256.f));
    const float a = (float)(r < 256 ? r : r - 256) * om;
    pe[i] = (dd >> 8) ? cosf(a) : sinf(a);
  }
  bf16_t* wd = (bf16_t*)(PWS() + OFF_W_DFT);
  for (size_t i = gtid; i < (size_t)256 * 256; i += gsz) {
    const int n = (int)(i >> 8), cc = (int)(i & 255), m = n >> 1, s = n & 1;
    float v;
    if (m == 0) v = s ? ((cc & 1) ? -1.f : 1.f) : 1.f;
    else { const float fr = (float)((cc * m) & 255) * (1.f / 256.f); v = s ? -__builtin_amdgcn_sinf(fr) : __builtin_amdgcn_cosf(fr); }
    wd[i] = f2bf(v);
  }
}

DEV void fold_wqk(const Params& p) {
  float* Ks = (float*)smem;
  float* Ws = Ks + 128 * 129;
  const int tid = TIDX();
  for (int item = BIDX(); item < 4 * 16 * 8; item += GDIM()) {
    const int l = item >> 7, hp = (item >> 3) & 15, ntile = item & 7;
    const float* keys = PIN(I_PKKEYS) + ((size_t)(l * 16 + hp) * 128) * 128;
    const float* wq = PIN(I_PKWQ) + (size_t)l * 1024 * 2048 + (size_t)(ntile * 128) * 2048 + hp * 128;
    for (int i = tid; i < 128 * 32; i += NT) {
      const int r = i >> 5, c4 = (i & 31) * 4;
      const float4 a = *(const float4*)(keys + (size_t)r * 128 + c4);
      Ks[r * 129 + c4] = a.x; Ks[r * 129 + c4 + 1] = a.y; Ks[r * 129 + c4 + 2] = a.z; Ks[r * 129 + c4 + 3] = a.w;
      const float4 b = *(const float4*)(wq + (size_t)r * 2048 + c4);
      Ws[r * 129 + c4] = b.x; Ws[r * 129 + c4 + 1] = b.y; Ws[r * 129 + c4 + 2] = b.z; Ws[r * 129 + c4 + 3] = b.w;
    }
    __syncthreads();
    const int ty = tid >> 4, tx = tid & 15;
    float acc[4][8];
#pragma unroll
    for (int i = 0; i < 4; ++i)
#pragma unroll
      for (int j = 0; j < 8; ++j) acc[i][j] = 0.f;
    for (int d = 0; d < 128; ++d) {
      float a[4], b[8];
#pragma unroll
      for (int i = 0; i < 4; ++i) a[i] = Ks[(ty * 4 + i) * 129 + d];
#pragma unroll
      for (int j = 0; j < 8; ++j) b[j] = Ws[(tx * 8 + j) * 129 + d];
#pragma unroll
      for (int i = 0; i < 4; ++i)
#pragma unroll
        for (int j = 0; j < 8; ++j) acc[i][j] += a[i] * b[j];
    }
    bf16_t* dst = (bf16_t*)(PWS() + OFF_WQK) + (size_t)l * 2048 * 1024;
#pragma unroll
    for (int i = 0; i < 4; ++i) {
      uint4 o; o.x = pack2(acc[i][0], acc[i][1]); o.y = pack2(acc[i][2], acc[i][3]); o.z = pack2(acc[i][4], acc[i][5]); o.w = pack2(acc[i][6], acc[i][7]);
      *(uint4*)(dst + (size_t)(hp * 128 + ty * 4 + i) * 1024 + ntile * 128 + tx * 8) = o;
    }
    __syncthreads();
  }
}

DEV float sin_hw(float x) { const float r = x * 0.15915494309189535f; return __builtin_amdgcn_sinf(r - floorf(r)); }
DEV void hyena_filter(const Params& p, int j, bool with_ctx) {
  float* feat = (float*)smem;
  float* h1 = feat + 64 * 33;
  float* h2t = h1 + 64 * 64;
  const int tid = TIDX();
  const float* W1 = PIN(I_HYFW1) + (size_t)j * 33 * 64; const float* B1 = PIN(I_HYFB1) + j * 64;
  const float* W2 = PIN(I_HYFW2) + (size_t)j * 64 * 64; const float* B2 = PIN(I_HYFB2) + j * 64;
  const float* W3 = PIN(I_HYFW3) + (size_t)j * 64 * 2048;
  const int nitems = 256 + (with_ctx ? 4 : 0);
  for (int item = BIDX(); item < nitems; item += GDIM()) {
    const bool isctx = item >= 256;
    const int Ls = isctx ? 256 : 16384;
    const int n0 = (isctx ? item - 256 : item) * 64;
    float* FW = (float*)(PWS() + OFF_FILT) + (isctx ? (size_t)2 * 1024 * 16384 : 0);
    float* BW = FW + (size_t)1024 * Ls;
    const float invL = 1.f / (float)Ls;
    int tq = TIDX(); asm volatile("" : "+v"(tq));
    {
      const int pp = tq >> 3, fg = tq & 7;
      const float t = (float)(n0 + pp) * invL;
#pragma unroll
      for (int i = 0; i < 5; ++i) {
        const int f = fg + 8 * i;
        if (f < 33) {
          float v;
          if (f == 0) v = t;
          else {
            const int jb = (f - 1) & 15;
            const float band = 1e-4f + (float)jb * ((15.f - 1e-4f) / 15.f);
            const float rev = t * band;
            v = (f <= 16) ? __builtin_amdgcn_cosf(rev) : -__builtin_amdgcn_sinf(rev);
          }
          feat[pp * 33 + f] = v;
        }
      }
    }
    __syncthreads();
    {
      const int pp = tq >> 3, o0 = (tq & 7) * 8;
      float a[8];
#pragma unroll
      for (int i = 0; i < 8; ++i) a[i] = B1[o0 + i];
      for (int f = 0; f < 33; ++f) {
        const float x = feat[pp * 33 + f];
#pragma unroll
        for (int i = 0; i < 8; ++i) a[i] += x * W1[f * 64 + o0 + i];
      }
#pragma unroll
      for (int i = 0; i < 8; ++i) h1[pp * 64 + o0 + i] = sin_hw(a[i]);
    }
    __syncthreads();
    {
      const int pp = tq >> 3, o0 = (tq & 7) * 8;
      float a[8];
#pragma unroll
      for (int i = 0; i < 8; ++i) a[i] = B2[o0 + i];
      for (int f = 0; f < 64; ++f) {
        const float x = h1[pp * 64 + f];
#pragma unroll
        for (int i = 0; i < 8; ++i) a[i] += x * W2[f * 64 + o0 + i];
      }
#pragma unroll
      for (int i = 0; i < 8; ++i) h2t[(o0 + i) * 64 + pp] = sin_hw(a[i]);
    }
    __syncthreads();
#pragma unroll 1
    for (int cs = 0; cs < 4; ++cs) {
      const int c2 = cs * 512 + tq;
      float acc[64];
#pragma unroll
      for (int n = 0; n < 64; ++n) acc[n] = 0.f;
#pragma unroll 1
      for (int kq = 0; kq < 4; ++kq) {
        float wv[16];
#pragma unroll
        for (int i = 0; i < 16; ++i) wv[i] = W3[(size_t)(kq * 16 + i) * 2048 + c2];
#pragma unroll
        for (int i = 0; i < 16; ++i) {
          const int kk = kq * 16 + i;
#pragma unroll
          for (int n4 = 0; n4 < 16; ++n4) {
            const float4 hv = *(const float4*)(h2t + kk * 64 + n4 * 4);
            acc[n4 * 4] += hv.x * wv[i]; acc[n4 * 4 + 1] += hv.y * wv[i]; acc[n4 * 4 + 2] += hv.z * wv[i]; acc[n4 * 4 + 3] += hv.w * wv[i];
          }
        }
      }
      const int cch = c2 & 1023;
      const float dmin = 3.0701134573253946f, dmax = 15.350567286626973f;
      const float delta = dmin + (dmax - dmin) * ((float)cch * (1.f / 1023.f));
      float* dst = ((c2 >> 10) ? BW : FW) + (size_t)cch * Ls + n0;
#pragma unroll
      for (int n4 = 0; n4 < 16; ++n4) {
        float4 o;
        o.x = acc[n4 * 4] * (__expf(-(float)(n0 + n4 * 4) * invL * delta) + 0.05f);
        o.y = acc[n4 * 4 + 1] * (__expf(-(float)(n0 + n4 * 4 + 1) * invL * delta) + 0.05f);
        o.z = acc[n4 * 4 + 2] * (__expf(-(float)(n0 + n4 * 4 + 2) * invL * delta) + 0.05f);
        o.w = acc[n4 * 4 + 3] * (__expf(-(float)(n0 + n4 * 4 + 3) * invL * delta) + 0.05f);
        *(float4*)(dst + n4 * 4) = o;
        if ((n4 & 3) == 3) __builtin_amdgcn_sched_barrier(0);
      }
    }
    __syncthreads();
  }
}

DEV void init_phase(const Params& p) {
  const int tid = TIDX(), lane = tid & 63, wave = tid >> 6;
  bf16_t* X = (bf16_t*)(PWS() + OFF_X);
  bf16_t* H = (bf16_t*)(PWS() + OFF_H);
  const float* MOD = (const float*)(PWS() + OFF_MOD);
  for (int row = BIDX() * 8 + wave; row < TT; row += GDIM() * 8) {
    float v[16];
    if (row < TL) {
      load16f(PIN(I_X) + (size_t)row * 1024 + lane * 16, v);
      const int t = row & 16383, gr = t >> 6, gc = t & 63;
      float pv[16];
      load16f((const float*)(PWS() + OFF_PE) + (size_t)(lane < 32 ? gr : 256 + gc) * 512 + (lane & 31) * 16, pv);
#pragma unroll
      for (int i = 0; i < 16; ++i) v[i] += pv[i];
    } else {
      load16f(PIN(I_CTX) + (size_t)(row - TL) * 1024 + lane * 16, v);
    }
    store16bf(X + (size_t)row * 1024 + lane * 16, v);
    const int mr = modrow_of(row);
    float sh[16], scl[16];
    load16f(mod_ptr(MOD, 0, mr, 0) + lane * 16, sh); load16f(mod_ptr(MOD, 0, mr, 1) + lane * 16, scl);
#pragma unroll
    for (int i = 0; i < 16; ++i) v[i] = v[i] * (1.f + scl[i]) + sh[i];
    store16bf(H + (size_t)row * 1024 + lane * 16, v);
  }
}
__device__ constexpr float C32[16] = {1.f, 0.98078528040323043f, 0.92387953251128674f, 0.83146961230254524f, 0.70710678118654752f, 0.55557023301960218f, 0.38268343236508977f, 0.19509032201612825f,
                                      0.f, -0.19509032201612825f, -0.38268343236508977f, -0.55557023301960218f, -0.70710678118654752f, -0.83146961230254524f, -0.92387953251128674f, -0.98078528040323043f};
__device__ constexpr float S32[16] = {0.f, 0.19509032201612825f, 0.38268343236508977f, 0.55557023301960218f, 0.70710678118654752f, 0.83146961230254524f, 0.92387953251128674f, 0.98078528040323043f,
                                      1.f, 0.98078528040323043f, 0.92387953251128674f, 0.83146961230254524f, 0.70710678118654752f, 0.55557023301960218f, 0.38268343236508977f, 0.19509032201612825f};
DEV float2 cmul(float2 a, float2 b) { return make_float2(a.x * b.x - a.y * b.y, a.x * b.y + a.y * b.x); }
DEV float2 cmulc(float2 a, float2 b) { return make_float2(a.x * b.x + a.y * b.y, a.y * b.x - a.x * b.y); }
constexpr int brev_c(int i, int bits) { int r = 0; for (int b = 0; b < bits; ++b) r |= ((i >> b) & 1) << (bits - 1 - b); return r; }

template <int R> DEV void fft_dif(float2 (&v)[R]) {
#pragma unroll
  for (int n = R; n >= 2; n >>= 1) {
    const int h = n >> 1;
#pragma unroll
    for (int base = 0; base < R; base += n) {
#pragma unroll
      for (int j = 0; j < h; ++j) {
        const float2 a = v[base + j], b = v[base + j + h];
        v[base + j] = make_float2(a.x + b.x, a.y + b.y);
        const float2 d = make_float2(a.x - b.x, a.y - b.y);
        const int m = j * (32 / n);
        if (m == 0) v[base + j + h] = d;
        else if (m == 8) v[base + j + h] = make_float2(d.y, -d.x);
        else v[base + j + h] = make_float2(d.x * C32[m] + d.y * S32[m], d.y * C32[m] - d.x * S32[m]);
      }
    }
    __builtin_amdgcn_sched_barrier(0);
  }
}
template <int R> DEV void ifft_dit(float2 (&v)[R]) {
#pragma unroll
  for (int n = 2; n <= R; n <<= 1) {
    const int h = n >> 1;
#pragma unroll
    for (int base = 0; base < R; base += n) {
#pragma unroll
      for (int j = 0; j < h; ++j) {
        const float2 a = v[base + j], b0 = v[base + j + h];
        const int m = j * (32 / n);
        float2 b;
        if (m == 0) b = b0;
        else if (m == 8) b = make_float2(-b0.y, b0.x);
        else b = make_float2(b0.x * C32[m] - b0.y * S32[m], b0.y * C32[m] + b0.x * S32[m]);
        v[base + j] = make_float2(a.x + b.x, a.y + b.y);
        v[base + j + h] = make_float2(a.x - b.x, a.y - b.y);
      }
    }
    __builtin_amdgcn_sched_barrier(0);
  }
}
DEV int amap(int pidx) { return pidx + (pidx >> 4) + (pidx >> 9); }
DEV float2 twid(int num, float inv_den) {
  const float fr = (float)num * inv_den;
  return make_float2(__builtin_amdgcn_cosf(fr), -__builtin_amdgcn_sinf(fr));
}

struct TwGen { float2 w1, w2, w4, w8, w16, w24, A; };
DEV void tw_init(TwGen& g, int num, float inv_den) {
  g.w1 = twid(num, inv_den); g.w2 = cmul(g.w1, g.w1); g.w4 = cmul(g.w2, g.w2); g.w8 = cmul(g.w4, g.w4); g.w16 = cmul(g.w8, g.w8); g.w24 = cmul(g.w8, g.w16);
  g.A = make_float2(1.f, 0.f);
}
DEV float2 tw_get(TwGen& g, int i) {
  const int blk = i >> 2, sub = i & 3;
  if (sub == 0) {
    if (blk == 0) g.A = make_float2(1.f, 0.f);
    else if (blk == 1) g.A = g.w4;
    else if (blk == 2) g.A = g.w2;
    else if (blk == 3) g.A = cmul(g.w2, g.w4);
    else if (blk == 4) g.A = g.w1;
    else if (blk == 5) g.A = cmul(g.w1, g.w4);
    else if (blk == 6) g.A = cmul(g.w1, g.w2);
    else g.A = cmul(cmul(g.w1, g.w2), g.w4);
    return g.A;
  }
  const float2 m = sub == 1 ? g.w16 : (sub == 2 ? g.w8 : g.w24);
  return blk == 0 ? m : cmul(g.A, m);
}
__device__ constexpr float C64[32] = {1.0f, 0.99518472667219693f, 0.98078528040323043f, 0.95694033573220882f, 0.92387953251128674f, 0.88192126434835505f, 0.83146961230254524f, 0.77301045336273699f, 0.70710678118654757f, 0.63439328416364549f, 0.55557023301960229f, 0.47139673682599781f, 0.38268343236508984f, 0.29028467725446233f, 0.19509032201612833f, 0.09801714032956077f, 6.123233995736766e-17f, -0.098017140329560645f, -0.19509032201612819f, -0.29028467725446216f, -0.38268343236508973f, -0.4713967368259977f, -0.55557023301960196f, -0.63439328416364538f, -0.70710678118654746f, -0.77301045336273699f, -0.83146961230254535f, -0.88192126434835494f, -0.92387953251128674f, -0.95694033573220882f, -0.98078528040323043f, -0.99518472667219682f};
__device__ constexpr float S64[32] = {0.0f, 0.098017140329560604f, 0.19509032201612825f, 0.29028467725446233f, 0.38268343236508978f, 0.47139673682599764f, 0.55557023301960218f, 0.63439328416364549f, 0.70710678118654746f, 0.77301045336273699f, 0.83146961230254524f, 0.88192126434835494f, 0.92387953251128674f, 0.95694033573220894f, 0.98078528040323043f, 0.99518472667219682f, 1.0f, 0.99518472667219693f, 0.98078528040323043f, 0.95694033573220894f, 0.92387953251128674f, 0.88192126434835505f, 0.83146961230254546f, 0.7730104533627371f, 0.70710678118654757f, 0.63439328416364549f, 0.55557023301960218f, 0.47139673682599786f, 0.38268343236508989f, 0.29028467725446239f, 0.19509032201612861f, 0.098017140329560826f};
DEV float2 tw_odd(float2 w0, int i) { return make_float2(w0.x * C64[i] + w0.y * S64[i], w0.y * C64[i] - w0.x * S64[i]); }

#define SB() __builtin_amdgcn_sched_barrier(0)
DEV void fft_fwd_pass1_store(float2 (&v)[32], float2* cx, int tid) {
  asm volatile("" : "+v"(tid));
  SB();
  fft_dif<32>(v);
  float2* base = cx + tid + (tid >> 4);
  TwGen g; tw_init(g, tid, 1.f / 16384.f);
#pragma unroll
  for (int i = 0; i < 32; ++i) {
    const int k1 = brev_c(i, 5);
    const float2 t = tw_get(g, i);
    base[k1 * 545] = cmul(v[i], t);
    if ((i & 3) == 3) SB();
  }
}
DEV void fft_fwd_pass2(float2* cx, int tid) {
  asm volatile("" : "+v"(tid));
  const int k1 = ((tid >> 4) & 1) * 16 + (tid >> 5), n00 = tid & 15;
  float2 v[32];
  float2* base = cx + k1 * 545 + n00;
#pragma unroll
  for (int i = 0; i < 32; ++i) v[i] = base[i * 17];
  SB();
  fft_dif<32>(v);
  TwGen g; tw_init(g, n00, 1.f / 512.f);
#pragma unroll
  for (int i = 0; i < 32; ++i) {
    const int k01 = brev_c(i, 5);
    const float2 t = tw_get(g, i);
    base[k01 * 17] = cmul(v[i], t);
    if ((i & 3) == 3) SB();
  }
}
DEV void fft_fwd_pass3_regs(const float2* cx, int tid, float2 (&w0)[16], float2 (&w1)[16]) {
  asm volatile("" : "+v"(tid));
  const float2* b0 = cx + tid * 17 + (tid >> 5);
  const float2* b1 = cx + (tid + 512) * 17 + ((tid + 512) >> 5);
#pragma unroll
  for (int i = 0; i < 16; ++i) { w0[i] = b0[i]; w1[i] = b1[i]; }
  SB();
  fft_dif<16>(w0); SB(); fft_dif<16>(w1); SB();
}
DEV void fft_inv_pass3_store(float2 (&w0)[16], float2 (&w1)[16], float2* cx, int tid) {
  asm volatile("" : "+v"(tid));
  SB(); ifft_dit<16>(w0); SB(); ifft_dit<16>(w1); SB();
  float2* b0 = cx + tid * 17 + (tid >> 5);
  float2* b1 = cx + (tid + 512) * 17 + ((tid + 512) >> 5);
#pragma unroll
  for (int i = 0; i < 16; ++i) { b0[i] = w0[i]; b1[i] = w1[i]; }
}
DEV void fft_inv_pass2(float2* cx, int tid) {
  asm volatile("" : "+v"(tid));
  const int k1 = ((tid >> 4) & 1) * 16 + (tid >> 5), n00 = tid & 15;
  float2 v[32];
  float2* base = cx + k1 * 545 + n00;
  TwGen g; tw_init(g, n00, 1.f / 512.f);
#pragma unroll
  for (int i = 0; i < 32; ++i) {
    const int k01 = brev_c(i, 5);
    const float2 t = tw_get(g, i);
    v[i] = cmulc(base[k01 * 17], t);
    if ((i & 3) == 3) SB();
  }
  ifft_dit<32>(v);
  SB();
#pragma unroll
  for (int i = 0; i < 32; ++i) base[i * 17] = v[i];
}
DEV void fft_inv_pass1_regs(const float2* cx, int tid, float2 (&v)[32]) {
  asm volatile("" : "+v"(tid));
  const float2* base = cx + tid + (tid >> 4);
  TwGen g; tw_init(g, tid, 1.f / 16384.f);
#pragma unroll
  for (int i = 0; i < 32; ++i) {
    const int k1 = brev_c(i, 5);
    const float2 t = tw_get(g, i);
    v[i] = cmulc(base[k1 * 545], t);
    if ((i & 3) == 3) SB();
  }
  ifft_dit<32>(v);
  SB();
}

DEV int seg_row0(int seg) { return seg < 2 ? seg * LSEQ : TL + (seg - 2) * CTXL; }
DEV int seg_len(int seg) { return seg < 2 ? LSEQ : CTXL; }
DEV size_t cm_off(int seg, int ch) { return seg < 2 ? ((size_t)(seg * 1024 + ch) * LSEQ) : ((size_t)2 * 1024 * LSEQ + (size_t)((seg - 2) * 1024 + ch) * CTXL); }

DEV void hy_prep(const Params& p, int j, bool with_ctx) {
  const bf16_t* U = (const bf16_t*)(PWS() + OFF_RA);
  bf16_t* X0 = (bf16_t*)(PWS() + OFF_RB);
  float* ZT = (float*)(PWS() + OFF_RB + (size_t)TT * D * 2);
  const float* CW = PIN(I_HYCONV) + (size_t)j * 3 * 3072;
  float* zt = (float*)smem;
  const int tid = TIDX();
  const int nlat = 2 * 256 * 16, nitems = nlat + (with_ctx ? 2 * 4 * 16 : 0);
  for (int item = BIDX(); item < nitems; item += GDIM()) {
    int seg, tt, ct;
    if (item < nlat) { seg = item >> 12; tt = (item >> 4) & 255; ct = item & 15; }
    else { const int r = item - nlat; seg = 2 + (r >> 6); tt = (r >> 4) & 3; ct = r & 15; }
    const int Ls = seg_len(seg), row0 = seg_row0(seg), t0 = tt * 64, c0 = ct * 64;
    {
      const int tl = tid >> 3, cg = tid & 7, t = t0 + tl, cc = c0 + cg * 8;
      float o[3][8];
#pragma unroll
      for (int s = 0; s < 3; ++s) {
#pragma unroll
        for (int i = 0; i < 8; ++i) o[s][i] = 0.f;
#pragma unroll
        for (int dt = 0; dt < 3; ++dt) {
          const int ts = t + dt - 1;
          if (ts >= 0 && ts < Ls) {
            const uint4 u = *(const uint4*)(U + (size_t)(row0 + ts) * 3072 + s * 1024 + cc);
            const float4 w0 = *(const float4*)(CW + dt * 3072 + s * 1024 + cc), w1 = *(const float4*)(CW + dt * 3072 + s * 1024 + cc + 4);
            o[s][0] += bflo(u.x) * w0.x; o[s][1] += bfhi(u.x) * w0.y; o[s][2] += bflo(u.y) * w0.z; o[s][3] += bfhi(u.y) * w0.w;
            o[s][4] += bflo(u.z) * w1.x; o[s][5] += bfhi(u.z) * w1.y; o[s][6] += bflo(u.w) * w1.z; o[s][7] += bfhi(u.w) * w1.w;
          }
        }
      }
      uint4 xo; xo.x = pack2(o[0][0], o[0][1]); xo.y = pack2(o[0][2], o[0][3]); xo.z = pack2(o[0][4], o[0][5]); xo.w = pack2(o[0][6], o[0][7]);
      *(uint4*)(X0 + (size_t)(row0 + t) * 1024 + cc) = xo;
#pragma unroll
      for (int i = 0; i < 8; ++i) zt[(cg * 8 + i) * 65 + tl] = o[2][i] * o[1][i];
    }
    __syncthreads();
    {
      const int cl = tid >> 3, tq = (tid & 7) * 8;
      float* dst = ZT + cm_off(seg, c0 + cl) + t0 + tq;
      *(float4*)dst = make_float4(zt[cl * 65 + tq], zt[cl * 65 + tq + 1], zt[cl * 65 + tq + 2], zt[cl * 65 + tq + 3]);
      *(float4*)(dst + 4) = make_float4(zt[cl * 65 + tq + 4], zt[cl * 65 + tq + 5], zt[cl * 65 + tq + 6], zt[cl * 65 + tq + 7]);
    }
    __syncthreads();
  }
}

DEV void hy_fft(const Params& p, int j, bool with_ctx) {
  const float* ZT = (const float*)(PWS() + OFF_RB + (size_t)TT * D * 2);
  float* YT = (float*)(PWS() + OFF_RA);
  const float* FW = (const float*)(PWS() + OFF_FILT);
  const float* BW = FW + (size_t)1024 * LSEQ;
  const float* SKIP = PIN(I_HYSKIP) + j * 1024;
  float2* cx = (float2*)smem;
  const int tid = TIDX();
  float2* spec = (float2*)(PWS() + OFF_RC) + (size_t)BIDX() * 16384;
  for (int ch = BIDX(); ch < 1024; ch += GDIM()) {
    const float* z0 = ZT + cm_off(0, ch); const float* z1 = ZT + cm_off(1, ch);
    float* y0 = YT + cm_off(0, ch); float* y1 = YT + cm_off(1, ch);
    const float* fw = FW + (size_t)ch * LSEQ; const float* bw = BW + (size_t)ch * LSEQ;
    const float skip = SKIP[ch];
#pragma unroll 1
    for (int odd = 0; odd < 2; ++odd) {
      {
        float2 v[32];
        int tq = tid; asm volatile("" : "+v"(tq));
        const float2 wo = twid(tq, 1.f / 32768.f);
#pragma unroll
        for (int i = 0; i < 32; ++i) {
          const int n = i * 512 + tq;
          const float hf = fw[n] + (n == 0 ? skip : 0.f), hb = (n > 0) ? bw[LSEQ - n] : 0.f;
          if (odd) { const float2 t = tw_odd(wo, i); const float d = hf - hb; v[i] = make_float2(d * t.x, d * t.y); }
          else v[i] = make_float2(hf + hb, 0.f);
          if ((i & 15) == 15) SB();
        }
        fft_fwd_pass1_store(v, cx, tid);
      }
      __syncthreads();
      fft_fwd_pass2(cx, tid);
      __syncthreads();
      {
        float2 f0[16], f1[16];
        fft_fwd_pass3_regs(cx, tid, f0, f1);
        float2* sp = spec + tid; asm volatile("" : "+v"(sp));
#pragma unroll
        for (int i = 0; i < 16; ++i) { sp[i * 512] = f0[i]; sp[(16 + i) * 512] = f1[i]; }
      }
      __syncthreads();
      {
        float2 v[32];
        int tq = tid; asm volatile("" : "+v"(tq));
        const float2 wo = twid(tq, 1.f / 32768.f);
#pragma unroll
        for (int i = 0; i < 32; ++i) {
          const int n = i * 512 + tq;
          const float2 w = make_float2(z0[n], z1[n]);
          v[i] = odd ? cmul(w, tw_odd(wo, i)) : w;
          if ((i & 15) == 15) SB();
        }
        fft_fwd_pass1_store(v, cx, tid);
      }
      __syncthreads();
      fft_fwd_pass2(cx, tid);
      __syncthreads();
      {
        float2 w0[16], w1[16];
        fft_fwd_pass3_regs(cx, tid, w0, w1);
        const float2* sp = spec + tid; asm volatile("" : "+v"(sp));
#pragma unroll
        for (int i = 0; i < 16; ++i) { w0[i] = cmul(w0[i], sp[i * 512]); w1[i] = cmul(w1[i], sp[(16 + i) * 512]); }
        fft_inv_pass3_store(w0, w1, cx, tid);
      }
      __syncthreads();
      fft_inv_pass2(cx, tid);
      __syncthreads();
      {
        float2 v[32];
        fft_inv_pass1_regs(cx, tid, v);
        const float sc = 0.5f / 16384.f;
        int tq = tid; asm volatile("" : "+v"(tq));
        const float2 wo = twid(tq, 1.f / 32768.f);
#pragma unroll
        for (int i = 0; i < 32; ++i) {
          const int n = i * 512 + tq;
          if (!odd) { y0[n] = sc * v[i].x; y1[n] = sc * v[i].y; }
          else { const float2 r = cmulc(v[i], tw_odd(wo, i)); y0[n] += sc * r.x; y1[n] += sc * r.y; }
          if ((i & 15) == 15) SB();
        }
      }
      __syncthreads();
    }
  }
  if (with_ctx) {
    const float* FWc = FW + (size_t)2 * 1024 * LSEQ; const float* BWc = FWc + (size_t)1024 * CTXL;
    float* zs = (float*)smem; float* fs = zs + 8 * 256; float* bs = fs + 8 * 256;
    for (int item = BIDX(); item < 256; item += GDIM()) {
      const int b = item >> 7, c0 = (item & 127) * 8;
      for (int i = tid; i < 2048; i += NT) {
        const int cl = i >> 8, t = i & 255;
        zs[i] = ZT[cm_off(2 + b, c0 + cl) + t]; fs[i] = FWc[(size_t)(c0 + cl) * CTXL + t]; bs[i] = BWc[(size_t)(c0 + cl) * CTXL + t];
      }
      __syncthreads();
      for (int i = tid; i < 2048; i += NT) {
        const int cl = i >> 8, t = i & 255;
        float a = 0.f;
        for (int s = 0; s <= t; ++s) a += fs[cl * 256 + t - s] * zs[cl * 256 + s];
        for (int s = t + 1; s < 256; ++s) a += bs[cl * 256 + s - t] * zs[cl * 256 + s];
        YT[cm_off(2 + b, c0 + cl) + t] = a + SKIP[c0 + cl] * zs[i];
      }
      __syncthreads();
    }
  }
}

DEV void cm_to_tok(const Params& p, const float* src, const bf16_t* mul, bf16_t* dst, bool with_ctx) {
  float* tlb = (float*)smem;
  const int tid = TIDX();
  const int nlat = 2 * 64 * 16, nitems = nlat + (with_ctx ? 2 * 16 : 0);
  for (int item = BIDX(); item < nitems; item += GDIM()) {
    int seg, tt, ct;
    if (item < nlat) { seg = item >> 10; tt = (item >> 4) & 63; ct = item & 15; }
    else { const int r = item - nlat; seg = 2 + (r >> 4); tt = 0; ct = r & 15; }
    const int row0 = seg_row0(seg), t0 = tt * 256, c0 = ct * 64;
    {
      const int cl = tid >> 3, tq = tid & 7;
      const float* s = src + cm_off(seg, c0 + cl) + t0;
      float4 v[8];
#pragma unroll
      for (int j = 0; j < 8; ++j) v[j] = *(const float4*)(s + (tq + 8 * j) * 4);
#pragma unroll
      for (int j = 0; j < 8; ++j) { float* d = tlb + cl * 257 + (tq + 8 * j) * 4; d[0] = v[j].x; d[1] = v[j].y; d[2] = v[j].z; d[3] = v[j].w; }
    }
    __syncthreads();
    {
      const int tl = tid >> 1, cg = (tid & 1) * 32;
      const size_t o = (size_t)(row0 + t0 + tl) * 1024 + c0 + cg;
      uint4 m[4];
      if (mul) {
#pragma unroll
        for (int q = 0; q < 4; ++q) m[q] = *(const uint4*)(mul + o + 8 * q);
      }
#pragma unroll
      for (int q = 0; q < 4; ++q) {
        float v[8];
#pragma unroll
        for (int i = 0; i < 8; ++i) v[i] = tlb[(cg + 8 * q + i) * 257 + tl];
        if (mul) {
          v[0] *= bflo(m[q].x); v[1] *= bfhi(m[q].x); v[2] *= bflo(m[q].y); v[3] *= bfhi(m[q].y); v[4] *= bflo(m[q].z); v[5] *= bfhi(m[q].z); v[6] *= bflo(m[q].w); v[7] *= bfhi(m[q].w);
        }
        uint4 ov; ov.x = pack2(v[0], v[1]); ov.y = pack2(v[2], v[3]); ov.z = pack2(v[4], v[5]); ov.w = pack2(v[6], v[7]);
        *(uint4*)(dst + o + 8 * q) = ov;
      }
    }
    __syncthreads();
  }
}
DEV void fn_transpose(const Params& p) {
  const bf16_t* G = (const bf16_t*)(PWS() + OFF_RA);
  unsigned* GT = (unsigned*)(PWS() + OFF_RB);
  unsigned* tlb = (unsigned*)smem;
  const int tid = TIDX();
  for (int item = BIDX(); item < 2 * 64 * 16; item += GDIM()) {
    const int b = item >> 10, tt = (item >> 4) & 63, ct = item & 15;
    const int t0 = tt * 256, c0 = ct * 64;
    {
      const int tl = tid >> 1, cq = (tid & 1) * 32;
      const bf16_t* s = G + (size_t)(b * LSEQ + t0 + tl) * 1024 + c0 + cq;
      uint4 v[4];
#pragma unroll
      for (int j = 0; j < 4; ++j) v[j] = *(const uint4*)(s + 8 * j);
#pragma unroll
      for (int j = 0; j < 4; ++j) { unsigned* d = tlb + tl * 33 + (cq >> 1) + 4 * j; d[0] = v[j].x; d[1] = v[j].y; d[2] = v[j].z; d[3] = v[j].w; }
    }
    __syncthreads();
    {
      const int sq = tid >> 4, tq = (tid & 15) * 16;
      unsigned* d = GT + ((size_t)(b * 512 + (c0 >> 1) + sq) * LSEQ) + t0 + tq;
#pragma unroll
      for (int i = 0; i < 16; i += 4)
        *(uint4*)(d + i) = make_uint4(tlb[(tq + i) * 33 + sq], tlb[(tq + i + 1) * 33 + sq], tlb[(tq + i + 2) * 33 + sq], tlb[(tq + i + 3) * 33 + sq]);
    }
    __syncthreads();
  }
}
DEV void fn_fft(const Params& p) {
  const unsigned* GT = (const unsigned*)(PWS() + OFF_RB);
  float* YT = (float*)(PWS() + OFF_RA);
  float2* cx = (float2*)smem;
  const int tid = TIDX();
  for (int item = BIDX(); item < 1024; item += GDIM()) {
    const int b = item >> 9, sq = item & 511, g = sq >> 7, m = sq & 127;
    const unsigned* src = GT + (size_t)(b * 512 + sq) * LSEQ;
    {
      float2 v[32];
#pragma unroll
      for (int i = 0; i < 32; ++i) { const unsigned u = src[i * 512 + tid]; v[i] = make_float2(bflo(u), bfhi(u)); }
      fft_fwd_pass1_store(v, cx, tid);
    }
    __syncthreads();
    fft_fwd_pass2(cx, tid);
    __syncthreads();
    {
      float2 w0[16], w1[16];
      fft_fwd_pass3_regs(cx, tid, w0, w1);
#pragma unroll
      for (int i = 0; i < 16; ++i) { cx[amap(tid * 16 + brev_c(i, 4))] = w0[i]; cx[amap((tid + 512) * 16 + brev_c(i, 4))] = w1[i]; }
    }
    __syncthreads();
    const float sc = 1.f / 2048.f;
    float* ya = YT + (size_t)(b * 1024 + g * 256 + (m ? m : 0)) * LSEQ;
    float* yb = YT + (size_t)(b * 1024 + g * 256 + (m ? 256 - m : 128)) * LSEQ;
#pragma unroll 4
    for (int i = 0; i < 32; ++i) {
      const int k = i * 512 + tid, km = (LSEQ - k) & (LSEQ - 1);
      const float2 fk = cx[amap((k & 31) * 512 + ((k >> 5) & 31) * 16 + (k >> 10))];
      const float2 fm = cx[amap((km & 31) * 512 + ((km >> 5) & 31) * 16 + (km >> 10))];
      if (m) { ya[k] = fk.x * sc; yb[k] = fm.x * sc; }
      else { ya[k] = 0.5f * (fk.x + fm.x) * sc; yb[k] = 0.5f * (fk.y + fm.y) * sc; }
    }
    __syncthreads();
  }
}

DEV void post_mixer(const Params& p, int layer, const bf16_t* Yo, int nrows, bool dry) {
  const int tid = TIDX(), lane = tid & 63, wave = tid >> 6;
  bf16_t* X = (bf16_t*)(PWS() + OFF_X);
  bf16_t* H = (bf16_t*)(PWS() + OFF_H);
  const float* MOD = (const float*)(PWS() + OFF_MOD);
  const float* lg = PIN(I_LNG) + (size_t)(layer * 2 + 0) * 1024; const float* lb = PIN(I_LNB) + (size_t)(layer * 2 + 0) * 1024;
  const int nwaves_ = GDIM() * 8, nfull_ = nrows / nwaves_, rem_ = nrows - nfull_ * nwaves_;
  for (int it_ = 0; it_ <= nfull_; ++it_) {
    int row = it_ * nwaves_ + BIDX() * 8 + wave;
    if (it_ == nfull_) { const int t_ = wave * GDIM() + BIDX(); if (t_ >= rem_) break; row = nfull_ * nwaves_ + t_; }
    const int mr = modrow_of(row);
    float x[16], y[16], gt[16];
    load16bf(X + (size_t)row * 1024 + lane * 16, x); load16bf(Yo + (size_t)row * 1024 + lane * 16, y);
    load16f(mod_ptr(MOD, layer, mr, 2) + lane * 16, gt);
#pragma unroll
    for (int i = 0; i < 16; ++i) x[i] = DN_ALPHA * x[i] + ((KO_MASK >> layer) & 1 ? 0.f : gt[i] * y[i]);
    ln_row(x, lg, lb, lane);
    if (!dry) store16bf(X + (size_t)row * 1024 + lane * 16, x);
    float sh[16], scl[16];
    load16f(mod_ptr(MOD, layer, mr, 3) + lane * 16, sh); load16f(mod_ptr(MOD, layer, mr, 4) + lane * 16, scl);
#pragma unroll
    for (int i = 0; i < 16; ++i) x[i] = x[i] * (1.f + scl[i]) + sh[i];
    if (!dry) store16bf(H + (size_t)row * 1024 + lane * 16, x);
    else if (x[0] == 1.2345e-30f) store16bf(H + (size_t)row * 1024 + lane * 16, x);
  }
}

typedef float f32x2 __attribute__((ext_vector_type(2)));
constexpr size_t OFF_P8 = OFF_PT;
constexpr size_t OFF_PSCL = OFF_PT + (size_t)2 * 16384 * 1024;
DEV unsigned fp6_code(float x, float sc) {
  const float a = fabsf(x) * sc;
  float c = a < 2.f ? rintf(a * 8.f) : (a < 4.f ? 16.f + rintf((a - 2.f) * 4.f) : 24.f + rintf((a - 4.f) * 2.f));
  c = fminf(c, 31.f);
  return (unsigned)c | (x < 0.f ? 32u : 0u);
}
DEV void peer_tables(const Params& p, int layer, int nrows) {
  const int tid = TIDX(), lane = tid & 63, wave = tid >> 6, l31 = lane & 31;
  int my_rank = BIDX(), n_share = GDIM();
  if (GDIM() % 8 == 0) {
    const int MT = nrows / 256, per_mt = 8, nloc_b = GDIM() / 8;
    const int XH = MT % 8, base = ((MT / 8) * per_mt) / nloc_b;
    const int JH = (XH > 0) ? ((MT / 8 + 1) * per_mt - base * nloc_b) : 0;
    if (JH > 0 && JH <= nloc_b && ((MT / 8) * per_mt) % nloc_b == 0) {
      const int bx = BIDX() % 8, bj = BIDX() / 8;
      const bool heavy = (bx < XH) && (bj < JH);
      const int before = (bj < JH) ? bj * XH + (bx < XH ? bx : XH) : JH * XH;
      n_share = GDIM() - JH * XH;
      my_rank = heavy ? -1 : BIDX() - before;
    }
  }
  if (my_rank < 0) return;
  const float* su = PIN(I_PKU) + (size_t)layer * 16384 * 1024; const float* sv = PIN(I_PKV) + (size_t)layer * 16384 * 1024;
  unsigned char* P8 = PWS() + OFF_P8; float* SCL = (float*)(PWS() + OFF_PSCL);
  for (int r2 = my_rank * 8 + wave; r2 < 8192; r2 += n_share * 8) {
    const int r = 2 * r2 + (lane >> 5);
    const float* src = su + (size_t)r * 1024 + l31 * 32;
    float x[32];
#pragma unroll
    for (int i = 0; i < 8; ++i) { const float4 v = *(const float4*)(src + 4 * i); x[4 * i] = v.x; x[4 * i + 1] = v.y; x[4 * i + 2] = v.z; x[4 * i + 3] = v.w; }
    float mx = 0.f;
#pragma unroll
    for (int i = 0; i < 32; ++i) mx = fmaxf(mx, fabsf(x[i]));
#pragma unroll
    for (int o = 16; o > 0; o >>= 1) mx = fmaxf(mx, SHX(mx, o));
    const float sc = mx > 0.f ? 7.5f / mx : 1.f, inv = mx > 0.f ? mx * (1.f / 7.5f) : 1.f;
    unsigned long long acc = 0ull; int nb = 0; unsigned w[6]; int wi = 0;
#pragma unroll
    for (int i = 0; i < 32; ++i) {
      acc |= (unsigned long long)fp6_code(x[i], sc) << nb; nb += 6;
      if (nb >= 32) { w[wi++] = (unsigned)acc; acc >>= 32; nb -= 32; }
    }
    unsigned char* dst = P8 + (size_t)r * 768;
    *(uint4*)(dst + l31 * 16) = make_uint4(w[0], w[1], w[2], w[3]); *(uint2*)(dst + 512 + l31 * 8) = make_uint2(w[4], w[5]);
    if (l31 == 0) SCL[r] = inv;
  }
  for (int r2 = my_rank * 8 + wave; r2 < 8192; r2 += n_share * 8) {
    const int r = 2 * r2 + (lane >> 5);
    const float* src = sv + (size_t)r * 1024 + l31 * 32;
    float x[32];
#pragma unroll
    for (int i = 0; i < 8; ++i) { const float4 v = *(const float4*)(src + 4 * i); x[4 * i] = v.x; x[4 * i + 1] = v.y; x[4 * i + 2] = v.z; x[4 * i + 3] = v.w; }
    float mx = 0.f;
#pragma unroll
    for (int i = 0; i < 32; ++i) mx = fmaxf(mx, fabsf(x[i]));
#pragma unroll
    for (int o = 16; o > 0; o >>= 1) mx = fmaxf(mx, SHX(mx, o));
    const float sc = mx > 0.f ? 7.5f / mx : 1.f, inv = mx > 0.f ? mx * (1.f / 7.5f) : 1.f;
    unsigned long long acc = 0ull; int nb = 0; unsigned w[6]; int wi = 0;
#pragma unroll
    for (int i = 0; i < 32; ++i) {
      acc |= (unsigned long long)fp6_code(x[i], sc) << nb; nb += 6;
      if (nb >= 32) { w[wi++] = (unsigned)acc; acc >>= 32; nb -= 32; }
    }
    unsigned char* dst = P8 + (size_t)16384 * 1024 + (size_t)r * 768 + l31 * 24;
    *(uint2*)(dst) = make_uint2(w[0], w[1]); *(uint2*)(dst + 8) = make_uint2(w[2], w[3]); *(uint2*)(dst + 16) = make_uint2(w[4], w[5]);
    if (l31 == 0) SCL[16384 + r] = inv;
  }
}
typedef float v32f __attribute__((ext_vector_type(32)));
typedef unsigned v6u __attribute__((ext_vector_type(6)));
typedef unsigned u32x3v __attribute__((ext_vector_type(3)));
DEV void unpack16_fp8(const uint4& a, float (&f)[16]) {
  const unsigned q[4] = {a.x, a.y, a.z, a.w};
#pragma unroll
  for (int d = 0; d < 4; ++d) {
    const f32x2 lo = __builtin_amdgcn_cvt_pk_f32_fp8((int)q[d], false), hi = __builtin_amdgcn_cvt_pk_f32_fp8((int)q[d], true);
    f[4 * d] = lo[0]; f[4 * d + 1] = lo[1]; f[4 * d + 2] = hi[0]; f[4 * d + 3] = hi[1];
  }
}

__device__ constexpr unsigned char STAIR[64] = {
  0x00,0x01,0x02,0x03,0x04,0x05,0x06,0x07,0x08,0x09,0x0a,0x0b,0x0c,0x0d,0x0e,0x0f,
  0x10,0x11,0x12,0x13,0x14,0x15,0x16,0x17, 0x20,0x21,0x22,0x23,0x24, 0x30,0x31,0x32,
  0x33, 0x40,0x41,0x42, 0x50,0x51, 0x60,0x61, 0x70,0x71, 0x80,0x90,0xa0,0xb0,0xc0,0xd0,
  0xe0,0xf0, 0xff,0xff,0xff,0xff,0xff,0xff,0xff,0xff,0xff,0xff,0xff,0xff,0xff,0xff};

DEV void peer_route(const Params& p, int nrows) {
  const unsigned* TOPK = (const unsigned*)(PWS() + OFF_RA);
  int* IDX = (int*)(PWS() + OFF_RA + (size_t)TT * 256 * 4);
  float* GATE = (float*)(PWS() + OFF_RA + (size_t)TT * 256 * 4 + (size_t)TT * 128 * 4);
  unsigned char* li = smem;
  const int tid = TIDX();
  const int total = nrows * 8;
  for (int it = BIDX() * NT + tid; it < total; it += GDIM() * NT) {
    const int row = it >> 3, h = it & 7;
    const unsigned* src = TOPK + ((size_t)row * 16 + h * 2) * 16;
    unsigned ka[16], kb[16];
#pragma unroll
    for (int i = 0; i < 4; ++i) {
      const uint4 a = *(const uint4*)(src + 4 * i), b = *(const uint4*)(src + 16 + 4 * i);
      ka[4 * i] = a.x; ka[4 * i + 1] = a.y; ka[4 * i + 2] = a.z; ka[4 * i + 3] = a.w;
      kb[4 * i] = b.x; kb[4 * i + 1] = b.y; kb[4 * i + 2] = b.z; kb[4 * i + 3] = b.w;
    }
    float va[16], vb[16];
#pragma unroll
    for (int i = 0; i < 16; ++i) {
      va[i] = keyf(ka[i] & ~127u); vb[i] = keyf(kb[i] & ~127u);
      li[i * 512 + tid] = (unsigned char)(127u - (ka[i] & 127u)); li[(16 + i) * 512 + tid] = (unsigned char)(127u - (kb[i] & 127u));
    }
    unsigned best[16], cur[16];
#pragma unroll
    for (int q = 0; q < 4; ++q) {
#pragma unroll
      for (int i = 0; i < 16; ++i) {
        const int code = STAIR[q * 16 + i];
        if (code == 0xff) cur[i] = 0u;
        else cur[i] = (fkey(va[code >> 4] + vb[code & 15]) & ~255u) | (unsigned)code;
      }
      sort16_desc(cur);
      if (q == 0) {
#pragma unroll
        for (int i = 0; i < 16; ++i) best[i] = cur[i];
      } else merge16_desc(best, cur);
    }
    float cv[16], sum = 0.f;
    const float mx = keyf(best[0] & ~255u);
#pragma unroll
    for (int i = 0; i < 16; ++i) { cv[i] = __expf(keyf(best[i] & ~255u) - mx); sum += cv[i]; }
    const float inv = 1.f / sum;
    int* di = IDX + (size_t)row * 128 + h * 16; float* dg = GATE + (size_t)row * 128 + h * 16;
#pragma unroll
    for (int i = 0; i < 16; ++i) {
      const unsigned code = best[i] & 255u;
      const int i1 = li[(code >> 4) * 512 + tid], i2 = li[(16 + (code & 15)) * 512 + tid];
      di[i] = i1 * 128 + i2; dg[i] = cv[i] * inv;
    }
  }
}

typedef unsigned u32x4v __attribute__((ext_vector_type(4)));
DEV unsigned sorted_key_of(unsigned k0, unsigned k1, int s) {
  const unsigned a = (unsigned)__builtin_amdgcn_ds_bpermute((s >> 1) << 2, (int)k0);
  const unsigned b = (unsigned)__builtin_amdgcn_ds_bpermute((s >> 1) << 2, (int)k1);
  return (s & 1) ? b : a;
}
DEV void pe_sort_keys(const int* IDX, int row, int lane, bool dry, unsigned& k0, unsigned& k1) {
  int2 ii = *(const int2*)(IDX + (size_t)row * 128 + 2 * lane);
#if EXPERT_L2PROBE
  if (dry) { ii.x &= 2047; ii.y &= 2047; }
#endif
  k0 = ((unsigned)ii.x << 7) | (unsigned)(2 * lane); k1 = ((unsigned)ii.y << 7) | (unsigned)(2 * lane + 1);
#pragma unroll
  for (int ksz = 2; ksz <= 128; ksz <<= 1) {
#pragma unroll
    for (int j = ksz >> 1; j >= 1; j >>= 1) {
      if (j == 1) {
        const bool asc = ((2 * lane) & ksz) == 0;
        const unsigned mn = k0 < k1 ? k0 : k1, mx = k0 < k1 ? k1 : k0;
        k0 = asc ? mn : mx; k1 = asc ? mx : mn;
      } else {
        const int pl = lane ^ (j >> 1);
        const unsigned p0 = (unsigned)__builtin_amdgcn_ds_bpermute(pl << 2, (int)k0), p1 = (unsigned)__builtin_amdgcn_ds_bpermute(pl << 2, (int)k1);
        const bool asc = ((2 * lane) & ksz) == 0, low = ((2 * lane) & j) == 0;
        const bool tmin = (asc == low);
        k0 = tmin ? (k0 < p0 ? k0 : p0) : (k0 < p0 ? p0 : k0);
        k1 = tmin ? (k1 < p1 ? k1 : p1) : (k1 < p1 ? p1 : k1);
      }
    }
  }
}
DEV float fp6_val(unsigned code) {
  const float c = (float)(code & 31u);
  const float v = c < 16.f ? c * 0.125f : (c < 24.f ? 2.f + (c - 16.f) * 0.25f : 4.f + (c - 24.f) * 0.5f);
  return (code & 32u) ? -v : v;
}
DEV void pe_pack_x(int row, int lane, uint4& xh, uint4& xl, float& inv_s) {
  float hb[16];
  const bf16_t* H = (const bf16_t*)(PWS() + OFF_H);
  const uint4 a = *(const uint4*)(H + (size_t)row * 1024 + lane * 16), b = *(const uint4*)(H + (size_t)row * 1024 + lane * 16 + 8);
  unpack16(a, b, hb);
  float mx = 0.f;
#pragma unroll
  for (int i = 0; i < 16; ++i) mx = fmaxf(mx, fabsf(hb[i]));
#pragma unroll
  for (int o_ = 32; o_ > 0; o_ >>= 1) mx = fmaxf(mx, SHX(mx, o_));
  const float s = mx > 0.f ? 7.5f / mx : 1.f; inv_s = mx > 0.f ? mx * (1.f / 7.5f) : 1.f;
  unsigned long long ah = 0ull, al = 0ull; int nb = 0; unsigned wh[3], wl[3]; int wi = 0;
#pragma unroll
  for (int i = 0; i < 16; ++i) {
    const float x = hb[i] * s;
    const unsigned ch = fp6_code(x, 1.f);
    const float lo = (x - fp6_val(ch)) * 16.f;
    const unsigned cl = fp6_code(lo, 1.f);
    ah |= (unsigned long long)ch << nb; al |= (unsigned long long)cl << nb; nb += 6;
    if (nb >= 32) { wh[wi] = (unsigned)ah; wl[wi] = (unsigned)al; ++wi; ah >>= 32; al >>= 32; nb -= 32; }
  }
  xh = make_uint4(wh[0], wh[1], wh[2], 0u); xl = make_uint4(wl[0], wl[1], wl[2], 0u);
}
DEV void pe_epilogue(int layer, int row, int nrows_next, bool dry, int lane, const f32x2 (&o2)[8]) {
  bf16_t* X = (bf16_t*)(PWS() + OFF_X);
  bf16_t* H = (bf16_t*)(PWS() + OFF_H);
  const float* MOD = (const float*)(PWS() + OFF_MOD);
  const float* lg = PIN(I_LNG) + (size_t)(layer * 2 + 1) * 1024; const float* lb = PIN(I_LNB) + (size_t)(layer * 2 + 1) * 1024;
  const int mr = modrow_of(row);
  float x[16], gt[16];
  load16bf(X + (size_t)row * 1024 + lane * 16, x); load16f(mod_ptr(MOD, layer, mr, 5) + lane * 16, gt);
#pragma unroll
  for (int i = 0; i < 16; ++i) x[i] = DN_ALPHA * x[i] + ((KO_MASK >> (4 + layer)) & 1 ? 0.f : gt[i] * o2[i >> 1][i & 1]);
  ln_row(x, lg, lb, lane);
  if (dry) { if (x[0] == 1.2345e-30f) store16bf(X + (size_t)row * 1024 + lane * 16, x); }
  else if (layer == 3) {
    if (row < TL) store16f(POUT() + (size_t)row * 1024 + lane * 16, x);
  } else {
    store16bf(X + (size_t)row * 1024 + lane * 16, x);
    if (row < nrows_next) {
      float sh[16], scl[16];
      load16f(mod_ptr(MOD, layer + 1, mr, 0) + lane * 16, sh); load16f(mod_ptr(MOD, layer + 1, mr, 1) + lane * 16, scl);
#pragma unroll
      for (int i = 0; i < 16; ++i) x[i] = x[i] * (1.f + scl[i]) + sh[i];
      store16bf(H + (size_t)row * 1024 + lane * 16, x);
    }
  }
}
DEV void peer_expert(const Params& p, int layer, int nrows, int nrows_next, bool dry) {
  const int tid = TIDX(), lane_f = tid & 63, wave = tid >> 6;
  const int npairs = nrows >> 1, nwaves = GDIM() * 8, nfull = npairs / nwaves, rem = npairs - nfull * nwaves;
  for (int it = 0; it <= nfull; ++it) {
    int rp = it * nwaves + BIDX() * 8 + wave;
    if (it == nfull) { const int t_ = wave * GDIM() + BIDX(); if (t_ >= rem) break; rp = nfull * nwaves + t_; }
    int lane = lane_f; asm volatile("" : "+v"(lane));
    const int rowA = 2 * rp, rowB = 2 * rp + 1;
    const unsigned char* PU8 = PWS() + OFF_P8;
    const float* SCU = (const float*)(PWS() + OFF_PSCL); const float* SCV = SCU + 16384;
    const int* IDX = (const int*)(PWS() + OFF_RA + (size_t)TT * 256 * 4);
    const float* GATE = (const float*)(PWS() + OFF_RA + (size_t)TT * 256 * 4 + (size_t)TT * 128 * 4);
    const int pkL = lane & 15, qL = lane >> 4;
    f32x2 oA[8], oB[8];
#pragma unroll
    for (int i = 0; i < 8; ++i) { oA[i] = (f32x2){0.f, 0.f}; oB[i] = (f32x2){0.f, 0.f}; }
    const __amdgpu_buffer_rsrc_t trs = __builtin_amdgcn_make_buffer_rsrc((void*)PU8, (short)0, 0x7fffffff, 0x00027000);
#define LOADU16(eLv) { if (lane < 48) { _Pragma("unroll") for (int k_ = 0; k_ < 16; ++k_) { \
        const int e_ = __builtin_amdgcn_readlane((eLv), k_); \
        __builtin_amdgcn_raw_ptr_buffer_load_lds(trs, (LAS void*)(smem + 16384 + k_ * 784 + p.ph_lo * 12544), 16, lane * 16, e_ * 768, 0, 0); } } }
#define LOADV8(q, eLv, hf) { _Pragma("unroll") for (int k_ = 0; k_ < 8; ++k_) { \
        const int e_ = __builtin_amdgcn_readlane((eLv), 8 * (hf) + k_); \
        q[k_] = __builtin_amdgcn_raw_buffer_load_b96(trs, 16384 * 1024 + e_ * 768 + lane * 12, 0, 0); } }
#define P64(lo_, hi_) ((long)(((unsigned long)(hi_) << 32) | (unsigned long)(lo_)))
#define DOTU2(t0) { _Pragma("unroll") for (int k_ = 0; k_ < 2; ++k_) { \
        const uint4 xa_ = *(const uint4*)(smem + xoff + ((t0) + k_) * 64); const uint2 xb_ = *(const uint2*)(smem + xoff2 + ((t0) + k_) * 32); \
        const uint4 b0_ = *(const uint4*)(smem + uoff + ((t0) + k_) * 64); const uint2 b1_ = *(const uint2*)(smem + uoff2 + ((t0) + k_) * 32); \
        const v8i32 a_ = {(int)xa_.x, (int)xa_.y, (int)xa_.z, (int)xa_.w, (int)xb_.x, (int)xb_.y, 0, 0}; \
        const v8i32 b_ = {(int)b0_.x, (int)b0_.y, (int)b0_.z, (int)b0_.w, (int)b1_.x, (int)b1_.y, 0, 0}; \
        if (k_ == 0) acc0 = __builtin_amdgcn_mfma_scale_f32_16x16x128_f8f6f4(a_, b_, acc0, 2, 2, 0, 0, 0, 0); \
        else acc1 = __builtin_amdgcn_mfma_scale_f32_16x16x128_f8f6f4(a_, b_, acc1, 2, 2, 0, 0, 0, 0); } \
        __builtin_amdgcn_sched_barrier(0); }
#define AXPY8(q, hf, o2) { _Pragma("unroll") for (int k_ = 0; k_ < 8; k_ += 2) { \
        const float wa_ = __uint_as_float(__builtin_amdgcn_readlane(__float_as_uint(wL), 8 * (hf) + k_)); \
        const float wb_ = __uint_as_float(__builtin_amdgcn_readlane(__float_as_uint(wL), 8 * (hf) + k_ + 1)); \
        const f32x2 wa2_ = {wa_, wa_}, wb2_ = {wb_, wb_}; \
        const v32f f_ = __builtin_amdgcn_cvt_scalef32_pk32_f32_fp6((v6u){q[k_][0], q[k_][1], q[k_][2], q[k_ + 1][0], q[k_ + 1][1], q[k_ + 1][2]}, 1.0f); \
        _Pragma("unroll") for (int d_ = 0; d_ < 8; ++d_) { \
          o2[d_] = __builtin_elementwise_fma(wa2_, (f32x2){f_[2 * d_], f_[2 * d_ + 1]}, o2[d_]); \
          o2[d_] = __builtin_elementwise_fma(wb2_, (f32x2){f_[16 + 2 * d_], f_[16 + 2 * d_ + 1]}, o2[d_]); } \
        __builtin_amdgcn_sched_barrier(0); } }
    unsigned k0A, k1A, k0B, k1B;
    pe_sort_keys(IDX, rowA, lane, dry, k0A, k1A);
    __builtin_amdgcn_sched_barrier(0);
    pe_sort_keys(IDX, rowB, lane, dry, k0B, k1B);
    __builtin_amdgcn_sched_barrier(0);
    uint4 xhA, xlA, xhB, xlB; float isA, isB;
    pe_pack_x(rowA, lane, xhA, xlA, isA);
    pe_pack_x(rowB, lane, xhB, xlB, isB);
    __builtin_amdgcn_sched_barrier(0);
#define SKEY(R, g_) sorted_key_of(k0##R, k1##R, 16 * (g_) + pkL)
    u32x3v qa[8], qb[8];
    const unsigned kA0 = SKEY(A, 0), kB0 = SKEY(B, 0);
    int eLA = (int)(kA0 >> 7), eLB = (int)(kB0 >> 7);
    float gLA = GATE[(size_t)rowA * 128 + (kA0 & 127u)], gLB = GATE[(size_t)rowB * 128 + (kB0 & 127u)];
    float suA = SCU[eLA] * isA, svA = SCV[eLA], suB = SCU[eLB] * isB, svB = SCV[eLB];
    LOADU16(eLA);
    __builtin_amdgcn_sched_barrier(0);
    LOADV8(qa, eLA, 0);
    LOADV8(qb, eLA, 1);
    __builtin_amdgcn_sched_barrier(0);
#define STEP(R, N, gnext, NEXT) { \
      const unsigned kLn = SKEY(R, gnext);                            \
      const int eLn = (int)(kLn >> 7); \
      const float gLn = GATE[(size_t)row##R * 128 + (kLn & 127u)]; \
      const float sun = SCU[eLn] * is##R, svn = SCV[eLn]; \
      { unsigned char* xs = smem + wave * 2048; const int g_ = lane >> 1, h_ = lane & 1; \
          \
        const int a0_ = h_ ? 16 * g_ + 12 : 16 * g_, a1_ = h_ ? 512 + 8 * g_ : 16 * g_ + 4, a2_ = h_ ? 512 + 8 * g_ + 4 : 16 * g_ + 8; \
        *(unsigned*)(xs + a0_) = xh##R.x; *(unsigned*)(xs + a1_) = xh##R.y; *(unsigned*)(xs + a2_) = xh##R.z; \
        *(unsigned*)(xs + 768 + a0_) = xl##R.x; *(unsigned*)(xs + 768 + a1_) = xl##R.y; *(unsigned*)(xs + 768 + a2_) = xl##R.z; \
        __builtin_amdgcn_fence(__ATOMIC_RELEASE, "wavefront"); __builtin_amdgcn_wave_barrier(); __builtin_amdgcn_fence(__ATOMIC_ACQUIRE, "wavefront"); } \
      f32x4 acc0 = (f32x4){0.f, 0.f, 0.f, 0.f}, acc1 = (f32x4){0.f, 0.f, 0.f, 0.f}; \
      int xoff = wave * 2048 + (pkL == 1 ? 768 : 0) + qL * 16; asm volatile("" : "+v"(xoff)); \
      int xoff2 = wave * 2048 + (pkL == 1 ? 768 : 0) + 512 + qL * 8; asm volatile("" : "+v"(xoff2)); \
      int uoff = 16384 + wave * 12544 + pkL * 784 + qL * 16; asm volatile("" : "+v"(uoff)); \
      int uoff2 = 16384 + wave * 12544 + pkL * 784 + 512 + qL * 8; asm volatile("" : "+v"(uoff2)); \
      __builtin_amdgcn_sched_barrier(0); \
      asm volatile("s_waitcnt vmcnt(16)" ::: "memory"); \
      __builtin_amdgcn_sched_barrier(0); \
      DOTU2(0); DOTU2(2); DOTU2(4); DOTU2(6); \
      const float r1 = (acc0[0] + acc1[0]) + (acc0[1] + acc1[1]) * 0.0625f; \
      float wL = gL##R * gelu_tanh(r1 * su##R) * sv##R; asm volatile("" : "+v"(wL) :: "memory");     \
      __builtin_amdgcn_sched_barrier(0); \
      if (NEXT) { LOADU16(eL##N); } \
      __builtin_amdgcn_sched_barrier(0); \
      AXPY8(qa, 0, o##R); \
      if (NEXT) { LOADV8(qa, eL##N, 0); } \
      __builtin_amdgcn_sched_barrier(0); \
      AXPY8(qb, 1, o##R); \
      if (NEXT) { LOADV8(qb, eL##N, 1); } \
      __builtin_amdgcn_sched_barrier(0); \
      eL##R = eLn; gL##R = gLn; su##R = sun; sv##R = svn; }
#pragma unroll 1
    for (int gI = 0; gI < 7; ++gI) { STEP(A, B, gI + 1, 1) STEP(B, A, gI + 1, 1) }
    STEP(A, B, 7, 1)
    STEP(B, A, 7, 0)
#undef STEP
#undef SKEY
#undef LOADU16
#undef LOADV8
#undef DOTU2
#undef AXPY8
#undef P64
    __builtin_amdgcn_sched_barrier(0);
    pe_epilogue(layer, rowA, nrows_next, dry, lane, oA);
    __builtin_amdgcn_sched_barrier(0);
    pe_epilogue(layer, rowB, nrows_next, dry, lane, oB);
  }
}
constexpr size_t GD_U1 = (size_t)TT * D;
constexpr size_t OFF_GD_T = OFF_RA;
constexpr size_t OFF_GD_ATT = OFF_GD_T + (size_t)8320 * 4096 * 2;
constexpr size_t OFF_GD_SC = OFF_GD_ATT + (size_t)8320 * 4096 * 2;
constexpr size_t OFF_GD_AB = OFF_RC;
constexpr size_t OFF_GD_KT = OFF_GD_AB + AL((size_t)TT * 256 * 4);
constexpr size_t OFF_GD_G = OFF_GD_KT + AL((size_t)4160 * 8192 * 2);
constexpr size_t OFF_GD_BETA = OFF_GD_G + AL((size_t)16 * TT * 4);
static_assert(OFF_GD_SC + (size_t)8320 * 1024 <= OFF_RA + 3 * GD_U1 * 2, "gdn prep buffers must fit in the q,k,v part of U");
static_assert(OFF_GD_BETA + (size_t)16 * TT * 4 <= OFF_RC + SZ_RC, "gdn side buffers must fit RC");

DEV void gdn_conv(const Params& p) {
  const bf16_t* U = (const bf16_t*)(PWS() + OFF_RA);
  bf16_t* QKV = (bf16_t*)(PWS() + OFF_RB);
  const float* AB = (const float*)(PWS() + OFF_GD_AB);
  bf16_t* KT = (bf16_t*)(PWS() + OFF_GD_KT);
  float* GG = (float*)(PWS() + OFF_GD_G); float* BETA = (float*)(PWS() + OFF_GD_BETA);
  const float* CW = PIN(I_GDCONV);
  bf16_t* kt = (bf16_t*)smem;
  const int tid = TIDX();
  for (int item = BIDX(); item < 520 * 8; item += GDIM()) {
    const int ci = item >> 3, h = item & 7;
    const int row0 = ci * 64;
    const int segstart = row0 < TL ? (row0 & ~16383) : (TL + ((row0 - TL) & ~255));
    const int Ls = row0 < TL ? LSEQ : CTXL;
    const int tl = tid >> 3, dg = tid & 7, row = row0 + tl, tin = row - segstart, lane = tid & 63;
    const int col = h * 128 + dg * 16;
#pragma unroll
    for (int s = 0; s < 3; ++s) {
      float o[16];
#pragma unroll
      for (int i = 0; i < 16; ++i) o[i] = 0.f;
#pragma unroll
      for (int dt = 0; dt < 3; ++dt) {
        const int ts = tin + dt - 1;
        if (ts >= 0 && ts < Ls) {
          const bf16_t* up = U + (size_t)s * GD_U1 + (size_t)(row + dt - 1) * 1024 + col;
          const uint4 a = *(const uint4*)up, b = *(const uint4*)(up + 8);
          float u[16], w[16]; unpack16(a, b, u); load16f(CW + (size_t)dt * 3072 + s * 1024 + col, w);
#pragma unroll
          for (int i = 0; i < 16; ++i) o[i] += u[i] * w[i];
        }
      }
      float ss = 0.f;
#pragma unroll
      for (int i = 0; i < 16; ++i) { o[i] = silu_f(o[i]); ss += o[i] * o[i]; }
      if (s < 2) {
        ss += SHX(ss, 1); ss += SHX(ss, 2); ss += SHX(ss, 4);
        const float inv = rsqrtf(ss + 1e-6f) * (s == 0 ? 0.08838834764831845f : 1.f);
#pragma unroll
        for (int i = 0; i < 16; ++i) o[i] *= inv;
      }
      store16bf(QKV + (size_t)s * GD_U1 + (size_t)row * 1024 + col, o);
      if (s == 1) {
#pragma unroll
        for (int i = 0; i < 16; ++i) kt[(dg * 16 + i) * 72 + tl] = f2bf(o[i]);
      }
    }
    if (tid < 128) {
      const int dir = tid >> 6, t2 = tid & 63, r2 = row0 + t2;
      const float a = AB[(size_t)r2 * 256 + dir * 8 + h], bb = AB[(size_t)r2 * 256 + 16 + dir * 8 + h];
      const float xa = a + PIN(I_GDDTB)[dir * 8 + h];
      const float sp = fmaxf(xa, 0.f) + log1pf(__expf(-fabsf(xa)));
      GG[(size_t)(dir * 8 + h) * TT + r2] = -__expf(PIN(I_GDALOG)[dir * 8 + h]) * sp;
      BETA[(size_t)(dir * 8 + h) * TT + r2] = 1.f / (1.f + __expf(-bb));
    }
    __syncthreads();
    {
      const int dk = tid >> 2, pq = (tid & 3) * 16;
      const bf16_t* s = kt + dk * 72 + pq;
      bf16_t* d = KT + ((size_t)item * 128 + dk) * 64 + pq;
      *(uint4*)d = *(const uint4*)s; *(uint4*)(d + 8) = *(const uint4*)(s + 8);
    }
    __syncthreads();
  }
}

DEV void gdn_prep(const Params& p) {
  const bf16_t* Qn = (const bf16_t*)(PWS() + OFF_RB); const bf16_t* Kn = Qn + GD_U1;
  const float* GG = (const float*)(PWS() + OFF_GD_G); const float* BETA = (const float*)(PWS() + OFF_GD_BETA);
  bf16_t* TM = (bf16_t*)(PWS() + OFF_GD_T); bf16_t* ATT = (bf16_t*)(PWS() + OFF_GD_ATT); float* SC = (float*)(PWS() + OFF_GD_SC);
  const int tid = TIDX(), lane = tid & 63, wave = tid >> 6, g = lane >> 4, c = lane & 15;
  float* As = (float*)smem + wave * 4096;
  const int nwaves_ = GDIM() * 8, nfull_ = 8320 / nwaves_, rem_ = 8320 - nfull_ * nwaves_;
  for (int it_ = 0; it_ <= nfull_; ++it_) {
    int item = it_ * nwaves_ + BIDX() * 8 + wave;
    if (it_ == nfull_) { const int t_ = wave * GDIM() + BIDX(); if (t_ >= rem_) break; item = nfull_ * nwaves_ + t_; }
    const int dir = item & 1, h = (item >> 1) & 7, ci = item >> 4;
    const int row0 = ci * 64;
    const int myrow = row0 + (dir ? 63 - lane : lane);
    const float gv = GG[(size_t)(dir * 8 + h) * TT + myrow], bv = BETA[(size_t)(dir * 8 + h) * TT + myrow];
    float gc = gv;
#pragma unroll
    for (int o = 1; o < 64; o <<= 1) { const float t = shfl_idx_f(gc, lane - o); if (lane >= o) gc += t; }
    const float gl = shfl_idx_f(gc, 63);
    bf16x8 kb[4][4];
#pragma unroll
    for (int ni = 0; ni < 4; ++ni) {
      const int pl = 16 * ni + c; const size_t r = (size_t)(row0 + (dir ? 63 - pl : pl));
#pragma unroll
      for (int s = 0; s < 4; ++s) kb[ni][s] = *(const bf16x8*)(Kn + r * 1024 + h * 128 + 32 * s + 8 * g);
    }
#pragma unroll 1
    for (int mi = 0; mi < 4; ++mi) {
      const int pl = 16 * mi + c; const size_t r = (size_t)(row0 + (dir ? 63 - pl : pl));
      f32x4 akk[4], aqk[4];
#pragma unroll
      for (int ni = 0; ni < 4; ++ni) { akk[ni] = (f32x4){0.f, 0.f, 0.f, 0.f}; aqk[ni] = (f32x4){0.f, 0.f, 0.f, 0.f}; }
#pragma unroll
      for (int s = 0; s < 4; ++s) {
        const bf16x8 ka = *(const bf16x8*)(Kn + r * 1024 + h * 128 + 32 * s + 8 * g);
        const bf16x8 qa = *(const bf16x8*)(Qn + r * 1024 + h * 128 + 32 * s + 8 * g);
#pragma unroll
        for (int ni = 0; ni < 4; ++ni) {
          akk[ni] = __builtin_amdgcn_mfma_f32_16x16x32_bf16(ka, kb[ni][s], akk[ni], 0, 0, 0);
          aqk[ni] = __builtin_amdgcn_mfma_f32_16x16x32_bf16(qa, kb[ni][s], aqk[ni], 0, 0, 0);
        }
      }
#pragma unroll
      for (int r_ = 0; r_ < 4; ++r_) {
        const int pr = 16 * mi + 4 * g + r_;
        const float gcr = shfl_idx_f(gc, pr), br = shfl_idx_f(bv, pr);
#pragma unroll
        for (int ni = 0; ni < 4; ++ni) {
          const int pc = 16 * ni + c;
          const float gcc = shfl_idx_f(gc, pc);
          const float dec = (pr >= pc) ? __expf(gcr - gcc) : 0.f;
          As[pr * 64 + pc] = (pr > pc) ? br * akk[ni][r_] * dec : 0.f;
          ATT[(size_t)item * 4096 + pr * 64 + pc] = f2bf(aqk[ni][r_] * dec);
        }
      }
    }
    float T[64];
#pragma unroll
    for (int i = 0; i < 64; ++i) {
      float acc = (i == lane) ? 1.f : 0.f;
#pragma unroll
      for (int j4 = 0; j4 < (i + 3) / 4; ++j4) {
        const float4 a = *(const float4*)(As + i * 64 + j4 * 4);
        if (j4 * 4 + 0 < i) acc -= a.x * T[j4 * 4 + 0];
        if (j4 * 4 + 1 < i) acc -= a.y * T[j4 * 4 + 1];
        if (j4 * 4 + 2 < i) acc -= a.z * T[j4 * 4 + 2];
        if (j4 * 4 + 3 < i) acc -= a.w * T[j4 * 4 + 3];
      }
      T[i] = acc;
    }
#pragma unroll
    for (int i = 0; i < 64; ++i) TM[(size_t)item * 4096 + i * 64 + lane] = f2bf(T[i]);
    float* sc = SC + (size_t)item * 256;
    sc[lane] = __expf(gc); sc[64 + lane] = __expf(gl - gc); sc[128 + lane] = bv; sc[192 + lane] = __expf(gl);
  }
}

constexpr int SCB = 74752;
constexpr int SC_K = 0, SC_Q = 17408, SC_KT = 34816, SC_T = 53248, SC_A = 62464, SC_V = 71680, SC_S = 73728;
DEV void scan_chunk_load(int c, int ci, int h, int dir, int slice, const bf16_t* Qn, const bf16_t* Kn, const bf16_t* Vn, const bf16_t* KT, const bf16_t* TM, const bf16_t* ATT, const float* SC,
                         uint4& r, int& dst) {
  const int row0 = ci * 64; const int item = (ci * 8 + h) * 2 + dir;
  if (c < 2048) { const int cc = c & 1023, pp = cc >> 4, ch = cc & 15; const int rr = row0 + (dir ? 63 - pp : pp);
    r = *(const uint4*)((c < 1024 ? Kn : Qn) + (size_t)rr * 1024 + h * 128 + ch * 8); dst = (c < 1024 ? SC_K : SC_Q) + pp * 272 + ch * 16; }
  else if (c < 3072) { const int cc = c - 2048, dk = cc >> 3, ch = cc & 7;
    r = *(const uint4*)(KT + ((size_t)(ci * 8 + h) * 128 + dk) * 64 + ch * 8); dst = SC_KT + dk * 144 + ch * 16; }
  else if (c < 4096) { const int cc = (c - 3072) & 511, pp = cc >> 3, ch = cc & 7;
    r = *(const uint4*)((c < 3584 ? TM : ATT) + (size_t)item * 4096 + pp * 64 + ch * 8); dst = (c < 3584 ? SC_T : SC_A) + pp * 144 + ch * 16; }
  else if (c < 4224) { const int cc = c - 4096, pp = cc >> 1, ch = cc & 1; const int rr = row0 + (dir ? 63 - pp : pp);
    r = *(const uint4*)(Vn + (size_t)rr * 1024 + h * 128 + slice * 16 + ch * 8); dst = SC_V + pp * 32 + ch * 16; }
  else { const int cc = (c < 4288 ? c : 4287) - 4224;
    r = *(const uint4*)(SC + (size_t)item * 256 + cc * 4); dst = SC_S + cc * 16; }
}
#define STG_DECL uint4 r0, r1, r2, r3, r4, r5, r6, r7, r8, r9; int d0, d1, d2, d3, d4, d5, d6, d7, d8, d9; \
  r0 = r1 = r2 = r3 = r4 = r5 = r6 = r7 = r8 = r9 = make_uint4(0u, 0u, 0u, 0u); d0 = d1 = d2 = d3 = d4 = d5 = d6 = d7 = d8 = d9 = 0;
#define STG_L1(i, n, lt_, nl_, ci_) if (i < n) scan_chunk_load((lt_) + (nl_) * i, (ci_), h, dir, slice, Qn, Kn, Vn, KT, TM, ATT, SC, r##i, d##i);
#define STG_LOAD(n, lt, nl, ci_) { int lt_ = (lt); asm volatile("" : "+v"(lt_));   \
  STG_L1(0, n, lt_, nl, ci_) STG_L1(1, n, lt_, nl, ci_) STG_L1(2, n, lt_, nl, ci_) STG_L1(3, n, lt_, nl, ci_) STG_L1(4, n, lt_, nl, ci_) \
  STG_L1(5, n, lt_, nl, ci_) STG_L1(6, n, lt_, nl, ci_) STG_L1(7, n, lt_, nl, ci_) STG_L1(8, n, lt_, nl, ci_) STG_L1(9, n, lt_, nl, ci_) }
#define STG_S1(i, n, buf_) if (i < n) *(uint4*)((buf_) + d##i) = r##i;
#define STG_STORE(n, buf_) { STG_S1(0, n, buf_) STG_S1(1, n, buf_) STG_S1(2, n, buf_) STG_S1(3, n, buf_) STG_S1(4, n, buf_) STG_S1(5, n, buf_) STG_S1(6, n, buf_) STG_S1(7, n, buf_) STG_S1(8, n, buf_) STG_S1(9, n, buf_) }
DEV bf16x8 pack8(const f32x4& a, const f32x4& b) {
  union { unsigned u[4]; bf16x8 v; } r;
  r.u[0] = pack2(a[0], a[1]); r.u[1] = pack2(a[2], a[3]); r.u[2] = pack2(b[0], b[1]); r.u[3] = pack2(b[2], b[3]);
  return r.v;
}
DEV bf16x8 ld2x8(const unsigned char* p0, const unsigned char* p1) {
  union { uint2 d[2]; bf16x8 v; } r;
  r.d[0] = *(const uint2*)p0; r.d[1] = *(const uint2*)p1;
  return r.v;
}
DEV uint2 rev4h(uint2 d) { return make_uint2((d.y >> 16) | (d.y << 16), (d.x >> 16) | (d.x << 16)); }
DEV bf16x8 ld2x8r(const unsigned char* p0, const unsigned char* p1) {
  union { uint2 d[2]; bf16x8 v; } r;
  r.d[0] = rev4h(*(const uint2*)p0); r.d[1] = rev4h(*(const uint2*)p1);
  return r.v;
}

DEV void gdn_scan(const Params& p) {
  const bf16_t* Qn = (const bf16_t*)(PWS() + OFF_RB); const bf16_t* Kn = Qn + GD_U1; const bf16_t* Vn = Kn + GD_U1;
  const bf16_t* KT = (const bf16_t*)(PWS() + OFF_GD_KT);
  const bf16_t* TM = (const bf16_t*)(PWS() + OFF_GD_T); const bf16_t* ATT = (const bf16_t*)(PWS() + OFF_GD_ATT); const float* SC = (const float*)(PWS() + OFF_GD_SC);
  bf16_t* O0 = (bf16_t*)(PWS() + OFF_H); bf16_t* O1 = (bf16_t*)(PWS() + OFF_FILT);
  const int tid = TIDX(), lane = tid & 63, g = lane >> 4, c = lane & 15;
  for (int task = BIDX(); task < 256; task += GDIM()) {
    const int chain = (task & 7) + 8 * (task >> 6), slice = (task >> 3) & 7;
    const int b = chain >> 4, h = (chain >> 1) & 7, dir = chain & 1;
    bf16_t* Od = dir ? O1 : O0;
    f32x4 S[8];
#pragma unroll
    for (int i = 0; i < 8; ++i) S[i] = (f32x4){0.f, 0.f, 0.f, 0.f};
    STG_DECL
    {
      const int ci0 = 512 + b * 4 + (dir ? 3 : 0);
      STG_LOAD(9, tid, NT, ci0)
      STG_STORE(9, smem)
      if (tid >= 64) { const int ci1 = 512 + b * 4 + (dir ? 2 : 1); STG_LOAD(10, tid - 64, NT - 64, ci1) }
    }
    __syncthreads();
#pragma unroll 1
    for (int step = 0; step < 260; ++step) {
      unsigned char* buf = smem + (step & 1) * SCB;
      const bool latent = step >= 4;
      const int ci = latent ? (b * 256 + (dir ? 255 - (step - 4) : (step - 4))) : (512 + b * 4 + (dir ? 3 - step : step));
      if (tid >= 64) {
        if (step + 1 < 260) { STG_STORE(10, smem + ((step + 1) & 1) * SCB) }
        if (step + 2 < 260) {
          const int s2 = step + 2;
          const int cin = (s2 >= 4) ? (b * 256 + (dir ? 255 - (s2 - 4) : (s2 - 4))) : (512 + b * 4 + (dir ? 3 - s2 : s2));
          STG_LOAD(10, tid - 64, NT - 64, cin)
        }
      } else {
        const float* scl = (const float*)(buf + SC_S);
#define FRAG(base, stride, mt, s) ld2x8((base) + (16 * (mt) + c) * (stride) + (32 * (s) + 4 * g) * 2, (base) + (16 * (mt) + c) * (stride) + (32 * (s) + 16 + 4 * g) * 2)
        bf16x8 Sb[4];
#pragma unroll
        for (int s = 0; s < 4; ++s) Sb[s] = pack8(S[2 * s], S[2 * s + 1]);
        bf16x8 kf[2][4], tf[4][2];
#pragma unroll
        for (int mt = 0; mt < 2; ++mt)
#pragma unroll
          for (int s = 0; s < 4; ++s) kf[mt][s] = FRAG(buf + SC_K, 272, mt, s);
        const float gl = scl[192];
#pragma unroll
        for (int mt = 0; mt < 4; ++mt)
#pragma unroll
          for (int s = 0; s < 2; ++s) tf[mt][s] = FRAG(buf + SC_T, 144, mt, s);
        __builtin_amdgcn_sched_barrier(0);
        f32x4 R[4];
#pragma unroll
        for (int hf = 0; hf < 2; ++hf) {
#pragma unroll
          for (int m2 = 0; m2 < 2; ++m2) {
            const int mt = 2 * hf + m2;
            f32x4 acc = (f32x4){0.f, 0.f, 0.f, 0.f};
#pragma unroll
            for (int s = 0; s < 4; ++s) acc = __builtin_amdgcn_mfma_f32_16x16x32_bf16(kf[m2][s], Sb[s], acc, 0, 0, 0);
#pragma unroll
            for (int r_ = 0; r_ < 4; ++r_) {
              const int pp = 16 * mt + 4 * g + r_;
              R[mt][r_] = scl[128 + pp] * (bf2f(*(const bf16_t*)(buf + SC_V + pp * 32 + c * 2)) - scl[pp] * acc[r_]);
            }
          }
          __builtin_amdgcn_sched_barrier(0);
#pragma unroll
          for (int m2 = 0; m2 < 2; ++m2)
#pragma unroll
            for (int s = 0; s < 4; ++s) kf[m2][s] = hf == 0 ? FRAG(buf + SC_K, 272, 2 + m2, s) : FRAG(buf + SC_Q, 272, m2, s);
          __builtin_amdgcn_sched_barrier(0);
        }
        bf16x8 Rb[2];
        Rb[0] = pack8(R[0], R[1]); Rb[1] = pack8(R[2], R[3]);
        f32x4 VN[4];
#pragma unroll
        for (int mt = 0; mt < 4; ++mt) {
          f32x4 acc = (f32x4){0.f, 0.f, 0.f, 0.f};
#pragma unroll
          for (int s = 0; s < 2; ++s) acc = __builtin_amdgcn_mfma_f32_16x16x32_bf16(tf[mt][s], Rb[s], acc, 0, 0, 0);
          VN[mt] = acc;
        }
#pragma unroll
        for (int mt = 0; mt < 4; ++mt)
#pragma unroll
          for (int s = 0; s < 2; ++s) tf[mt][s] = FRAG(buf + SC_A, 144, mt, s);
        __builtin_amdgcn_sched_barrier(0);
        if (latent) {
          bf16x8 Vb[2];
          Vb[0] = pack8(VN[0], VN[1]); Vb[1] = pack8(VN[2], VN[3]);
#pragma unroll
          for (int mt = 0; mt < 4; ++mt) {
            if (mt == 2) {
#pragma unroll
              for (int m2 = 0; m2 < 2; ++m2)
#pragma unroll
                for (int s = 0; s < 4; ++s) kf[m2][s] = FRAG(buf + SC_Q, 272, 2 + m2, s);
              __builtin_amdgcn_sched_barrier(0);
            }
            f32x4 acc = (f32x4){0.f, 0.f, 0.f, 0.f};
#pragma unroll
            for (int s = 0; s < 4; ++s) acc = __builtin_amdgcn_mfma_f32_16x16x32_bf16(kf[mt & 1][s], Sb[s], acc, 0, 0, 0);
#pragma unroll
            for (int r_ = 0; r_ < 4; ++r_) acc[r_] *= scl[16 * mt + 4 * g + r_];
#pragma unroll
            for (int s = 0; s < 2; ++s) acc = __builtin_amdgcn_mfma_f32_16x16x32_bf16(tf[mt][s], Vb[s], acc, 0, 0, 0);
#pragma unroll
            for (int r_ = 0; r_ < 4; ++r_) {
              const int pp = 16 * mt + 4 * g + r_;
              const size_t r = (size_t)(ci * 64 + (dir ? 63 - pp : pp));
              Od[r * 1024 + h * 128 + slice * 16 + c] = f2bf(acc[r_]);
            }
          }
        }
#pragma unroll
        for (int mt = 0; mt < 4; ++mt)
#pragma unroll
          for (int r_ = 0; r_ < 4; ++r_) VN[mt][r_] *= scl[64 + 16 * mt + 4 * g + r_];
        bf16x8 Wb[2];
        Wb[0] = pack8(VN[0], VN[1]); Wb[1] = pack8(VN[2], VN[3]);
#define KTFRAG(m8, s) (dir == 0 ? ld2x8(buf + SC_KT + (16 * (m8) + c) * 144 + (32 * (s) + 4 * g) * 2, buf + SC_KT + (16 * (m8) + c) * 144 + (32 * (s) + 16 + 4 * g) * 2) \
                                : ld2x8r(buf + SC_KT + (16 * (m8) + c) * 144 + (60 - 32 * (s) - 4 * g) * 2, buf + SC_KT + (16 * (m8) + c) * 144 + (44 - 32 * (s) - 4 * g) * 2))
#pragma unroll
        for (int hf = 0; hf < 2; ++hf) {
#pragma unroll
          for (int m4 = 0; m4 < 4; ++m4)
#pragma unroll
            for (int s = 0; s < 2; ++s) kf[m4 >> 1][2 * (m4 & 1) + s] = KTFRAG(4 * hf + m4, s);
          __builtin_amdgcn_sched_barrier(0);
#pragma unroll
          for (int m4 = 0; m4 < 4; ++m4) {
            f32x4 acc = S[4 * hf + m4] * gl;
#pragma unroll
            for (int s = 0; s < 2; ++s) acc = __builtin_amdgcn_mfma_f32_16x16x32_bf16(kf[m4 >> 1][2 * (m4 & 1) + s], Wb[s], acc, 0, 0, 0);
            S[4 * hf + m4] = acc;
          }
        }
#undef KTFRAG
#undef FRAG
      }
      asm volatile("s_waitcnt lgkmcnt(0)" ::: "memory");
      __builtin_amdgcn_s_barrier();
      asm volatile("" ::: "memory");
    }
    __syncthreads();
  }
}

DEV void gdn_out(const Params& p) {
  const bf16_t* O0 = (const bf16_t*)(PWS() + OFF_H); const bf16_t* O1 = (const bf16_t*)(PWS() + OFF_FILT);
  const bf16_t* Uz = (const bf16_t*)(PWS() + OFF_RA) + 3 * GD_U1;
  bf16_t* Y = (bf16_t*)(PWS() + OFF_PT);
  const float* NG = PIN(I_GDNORMG);
  const int tid = TIDX(), lane = tid & 63, wave = tid >> 6;
  for (int row = BIDX() * 8 + wave; row < TL; row += GDIM() * 8) {
    float a[16], b[16], z[16];
    { const uint4 x = *(const uint4*)(O0 + (size_t)row * 1024 + lane * 16), y = *(const uint4*)(O0 + (size_t)row * 1024 + lane * 16 + 8); unpack16(x, y, a); }
    { const uint4 x = *(const uint4*)(O1 + (size_t)row * 1024 + lane * 16), y = *(const uint4*)(O1 + (size_t)row * 1024 + lane * 16 + 8); unpack16(x, y, b); }
    { const uint4 x = *(const uint4*)(Uz + (size_t)row * 1024 + lane * 16), y = *(const uint4*)(Uz + (size_t)row * 1024 + lane * 16 + 8); unpack16(x, y, z); }
    float ss = 0.f;
#pragma unroll
    for (int i = 0; i < 16; ++i) { a[i] += b[i]; ss += a[i] * a[i]; }
    ss += SHX(ss, 1); ss += SHX(ss, 2); ss += SHX(ss, 4);
    const float inv = rsqrtf(ss * (1.f / 128.f) + 1e-6f);
    float ng[16]; load16f(NG + (lane & 7) * 16, ng);
#pragma unroll
    for (int i = 0; i < 16; ++i) a[i] = a[i] * inv * ng[i] * silu_f(z[i]);
    store16bf(Y + (size_t)row * 1024 + lane * 16, a);
  }
}
constexpr int N_PHASES = 39;

#define GEMM1(A, Bt, C, bias, M, N, K, lda, ldb, ldc, mode) gemm_phase(p, (const bf16_t*)(A), (const bf16_t*)(Bt), (void*)(C), (bias), (M), (N), (K), (lda), (ldb), (ldc), 1, (mode), 0L, 0L, 0L)
#define GEMMB(A, Bt, C, bias, M, N, K, lda, ldb, ldc, mode, nb, sA, sB, sC) gemm_phase(p, (const bf16_t*)(A), (const bf16_t*)(Bt), (void*)(C), (bias), (M), (N), (K), (lda), (ldb), (ldc), (nb), (mode), (long)(sA), (long)(sB), (long)(sC))

DEV void peer_phase(const Params& p, int layer, int sub, int nrows, int nrows_next) {
  unsigned char* ws = PWS();
  if (sub == 0) {
    REP(1) { GEMM1(ws + OFF_H, ws + OFF_WQK + (size_t)layer * 2048 * 1024 * 2, ws + OFF_RA, (const float*)nullptr, nrows, 2048, 1024, 1024, 1024, 0, 2); __syncthreads(); }
    REP(4) peer_tables(p, layer, nrows);
  } else if (sub == 1) { REP(4) peer_route(p, nrows); }
  else { REP(0) peer_expert(p, layer, nrows, nrows_next, DRY(0)); }
}

DEV void hyena_phase(const Params& p, int layer, int j, int sub, int nrows, bool with_ctx) {
  unsigned char* ws = PWS();
  switch (sub) {
    case 0:
      REP(1) { GEMM1(ws + OFF_H, ws + OFF_W_HYIN + (size_t)j * 3072 * 1024 * 2, ws + OFF_RA, PIN(I_HYINB) + j * 3072, nrows, 3072, 1024, 1024, 1024, 3072, 1); __syncthreads(); }
      if (j == 1) { REP(6) hyena_filter(p, 1, false); }
      break;
    case 1: REP(4) hy_prep(p, j, with_ctx); break;
    case 2: REP(2) hy_fft(p, j, with_ctx); break;
    case 3: REP(4) cm_to_tok(p, (const float*)(ws + OFF_RA), (const bf16_t*)(ws + OFF_RB), (bf16_t*)(ws + OFF_H), with_ctx); break;
    case 4:
      REP(1) { GEMM1(ws + OFF_H, ws + OFF_W_HYOUT + (size_t)j * 1024 * 1024 * 2, ws + OFF_RC, PIN(I_HYOUTB) + j * 1024, nrows, 1024, 1024, 1024, 1024, 1024, 1); __syncthreads(); }
      break;
    default: REP(5) post_mixer(p, layer, (const bf16_t*)(ws + OFF_RC), nrows, DRY(5)); break;
  }
}

DEV void run_phase(const Params& p, int ph) {
  unsigned char* ws = PWS();
  if (ph == 0) {
    REP(6) {
    const int skip_b = (GDIM() >= 64) ? 4 : 0;
    mod_gemv(p, skip_b); __syncthreads();
    weight_convert(p, skip_b); __syncthreads();
    fold_wqk(p); __syncthreads();
    hyena_filter(p, 0, true); __syncthreads();
    }
  } else if (ph == 1) {
    REP(6) init_phase(p);
  } else if (ph < 11) {
    const int s = ph - 2;
    if (s < 6) hyena_phase(p, 0, 0, s, TT, true); else peer_phase(p, 0, s - 6, TT, TT);
  } else if (ph < 21) {
    const int s = ph - 11;
    switch (s) {
      case 0: {
        REP(1) {
        GEMMB(ws + OFF_H, ws + OFF_W_GDIN, ws + OFF_RA, (const float*)nullptr, TT, 1024, 1024, 1024, 1024, 1024, 1, 4, 0, 1024 * 1024, GD_U1);
        GEMM1(ws + OFF_H, ws + OFF_W_GDAB, ws + OFF_GD_AB, (const float*)nullptr, TT, 256, 1024, 1024, 1024, 256, 0);
        __syncthreads(); }
      } break;
      case 1: REP(3) gdn_conv(p); break;
      case 2: REP(7) gdn_prep(p); break;
      case 3: REP(8) gdn_scan(p); break;
      case 4: REP(4) gdn_out(p); break;
      case 5: REP(1) { GEMM1(ws + OFF_PT, ws + OFF_W_GDOUT, ws + OFF_RB, (const float*)nullptr, TL, 1024, 1024, 1024, 1024, 1024, 1); __syncthreads(); } break;
      case 6: REP(5) post_mixer(p, 1, (const bf16_t*)(ws + OFF_RB), TL, DRY(5)); break;
      default: peer_phase(p, 1, s - 7, TL, TL); break;
    }
  } else if (ph < 30) {
    const int s = ph - 21;
    switch (s) {
      case 0: {
        REP(1) { GEMMB(ws + OFF_H, ws + OFF_W_DFT, ws + OFF_RA, (const float*)nullptr, TL, 256, 256, 1024, 256, 1024, 1, 4, 256, 0, 256); __syncthreads(); }
      } break;
      case 1: REP(4) fn_transpose(p); break;
      case 2: REP(2) fn_fft(p); break;
      case 3: REP(4) cm_to_tok(p, (const float*)(ws + OFF_RA), nullptr, (bf16_t*)(ws + OFF_H), false); break;
      case 4: REP(1) { GEMM1(ws + OFF_H, ws + OFF_W_FNOUT, ws + OFF_RC, PIN(I_FNOUTB), TL, 1024, 1024, 1024, 1024, 1024, 1); __syncthreads(); } break;
      case 5: REP(5) post_mixer(p, 2, (const bf16_t*)(ws + OFF_RC), TL, DRY(5)); break;
      default: peer_phase(p, 2, s - 6, TL, TL); break;
    }
  } else {
    const int s = ph - 30;
    if (s < 6) hyena_phase(p, 3, 1, s, TL, false); else peer_phase(p, 3, s - 6, TL, TL);
  }
}

DEV void ptab_init(const Params& p) {
  if (threadIdx.x == 0) {
#pragma unroll
    for (int i = 0; i < 31; ++i) g_ptab[i] = (unsigned long long)p.in[i];
    g_ptab[31] = (unsigned long long)p.out; g_ptab[32] = (unsigned long long)p.ws; g_ptab[33] = 0ull;
  }
  __syncthreads();
}
#if N_LAUNCH_MODE == 1
template <int PH> DEV void run_seq(const Params& p, cg::grid_group& grid, const XcdBarrier& xb) {
  run_phase(p, PH);
  if constexpr (PH + 1 < N_PHASES) {
    if constexpr (PH == 0) grid.sync();
    else { xcd_barrier(xb, p.ph_lo); if (BARRIER2) xcd_barrier(xb, p.ph_lo); }
    run_seq<PH + 1>(p, grid, xb);
  }
}
__global__ void __launch_bounds__(512) mega(Params p0) {
  cg::grid_group grid = cg::this_grid();
  if (threadIdx.x == 0) g_xbwords = make_uint4(0u, 0u, 0u, 0u);
  ptab_init(p0);
  if (blockIdx.x == 0) {
    unsigned* bar0 = (unsigned*)(p0.ws + OFF_BAR);
    for (int i = (int)threadIdx.x; i < 4096; i += NT) __hip_atomic_store(&bar0[i], 0u, __ATOMIC_RELAXED, __HIP_MEMORY_SCOPE_AGENT);
  }
  Params p; p.ph_lo = __builtin_amdgcn_readfirstlane((int)(threadIdx.x >> 6)); p.ph_hi = 0;
  run_phase(p, 0);
  grid.sync();
  const XcdBarrier xb = xcd_barrier_post((unsigned*)(p0.ws + OFF_BAR), (volatile LAS unsigned*)&g_xbwords);
  run_seq<1>(p, grid, xb);
}
#else
template <int PH> __global__ void __launch_bounds__(512) mega_one(Params p0) {
  ptab_init(p0);
  Params p; p.ph_lo = __builtin_amdgcn_readfirstlane((int)(threadIdx.x >> 6)); p.ph_hi = 0;
  run_phase(p, PH);
}
typedef void (*kern_t)(Params);
template <int PH> struct KTab { static void fill(kern_t* t) { t[PH] = mega_one<PH>; KTab<PH - 1>::fill(t); } };
template <> struct KTab<-1> { static void fill(kern_t*) {} };
#endif

extern "C" void kernel_launch(void* const* d_in, const int* in_sizes, int n_in, void* d_out, int out_size, void* d_ws, size_t ws_size, hipStream_t stream) {
  static int grid_blocks = 0;
#if N_LAUNCH_MODE != 1
  static kern_t ktab[N_PHASES];
#endif
  if (!grid_blocks) {
    int dev = 0, cus = 0, per_cu = 0;
    (void)hipGetDevice(&dev);
    (void)hipDeviceGetAttribute(&cus, hipDeviceAttributeMultiprocessorCount, dev);
#if N_LAUNCH_MODE == 1
    (void)hipFuncSetAttribute((const void*)mega, hipFuncAttributeMaxDynamicSharedMemorySize, LDS_BYTES);
    (void)hipOccupancyMaxActiveBlocksPerMultiprocessor(&per_cu, (const void*)mega, NT, LDS_BYTES);
    if (per_cu < 1) { fprintf(stderr, "occupancy query says %d blocks/CU\n", per_cu); per_cu = 1; }
#else
    KTab<N_PHASES - 1>::fill(ktab);
    for (int i = 0; i < N_PHASES; ++i) (void)hipFuncSetAttribute((const void*)ktab[i], hipFuncAttributeMaxDynamicSharedMemorySize, LDS_BYTES);
#endif
    grid_blocks = cus;
    if (ws_size < WS_END || n_in != 31) fprintf(stderr, "kernel_launch: unexpected ws_size %zu (need %zu) or n_in %d\n", ws_size, (size_t)WS_END, n_in);
  }
  Params p{};
  for (int i = 0; i < 31; ++i) p.in[i] = (const float*)d_in[i];
  p.out = (float*)d_out; p.ws = (unsigned char*)d_ws;
#if N_LAUNCH_MODE == 1
  p.ph_lo = 0; p.ph_hi = N_PHASES;
  void* args[] = {&p};
  hipError_t e = hipLaunchCooperativeKernel((const void*)mega, dim3(grid_blocks), dim3(NT), args, LDS_BYTES, stream);
  if (e != hipSuccess) fprintf(stderr, "cooperative launch failed: %s\n", hipGetErrorString(e));
#else
  p.ph_lo = 0; p.ph_hi = 0;
  for (int ph = 0; ph < N_PHASES; ++ph) {
    hipLaunchKernelGGL(ktab[ph], dim3(grid_blocks), dim3(NT), LDS_BYTES, stream, p);
  }
#endif
}
```
